# Optimizing an MI355X kernel written in HIP

```python
import jax, jax.numpy as jnp
from jax import lax
import numpy as np


D_MODEL = 1024
BATCH = 8
SEQ = 2048
DEPTH = 2

MIX_WIDTH = 256
CONV_K = 3
GMLP_GROUPS = 4
GMLP_CHUNK = 128
HEAD_DIM = 64
SB_HEADS = MIX_WIDTH // HEAD_DIM
FOX_HEADS = MIX_WIDTH // HEAD_DIM
Q_BLOCK = 128
N_BRANCH = 4
FFN_HIDDEN = -(-8 * D_MODEL // (3 * 256)) * 256
EPS = 1e-6
IN_SPLIT_SIZES = (MIX_WIDTH, MIX_WIDTH, MIX_WIDTH, 2 * MIX_WIDTH, MIX_WIDTH, MIX_WIDTH, MIX_WIDTH,
                  MIX_WIDTH, MIX_WIDTH, MIX_WIDTH, FOX_HEADS, N_BRANCH * D_MODEL)
N_IN = sum(IN_SPLIT_SIZES)

kernel_name = 'hybrid_gated_conv_gmlp_stickbreak_fox'


def _rms_norm(x, g):
    xf = x.astype(jnp.float32)
    y = xf * lax.rsqrt(jnp.mean(xf * xf, axis=-1, keepdims=True) + EPS)
    return (y * g.astype(jnp.float32)).astype(x.dtype)


def _layer_norm(x, g, b):
    xf = x.astype(jnp.float32)
    mu = jnp.mean(xf, axis=-1, keepdims=True)
    var = jnp.mean(jnp.square(xf - mu), axis=-1, keepdims=True)
    y = (xf - mu) * lax.rsqrt(var + EPS)
    return (y * g.astype(jnp.float32) + b.astype(jnp.float32)).astype(x.dtype)


def _split_heads(t, n_heads):
    b, s, _ = t.shape
    return t.reshape(b, s, n_heads, HEAD_DIM).transpose(0, 2, 1, 3)


def _merge_heads(t):
    b, h, s, d = t.shape
    return t.transpose(0, 2, 1, 3).reshape(b, s, h * d)


def _short_conv_mixer(b_gate, c_gate, xt, w_conv):
    xc = c_gate * xt
    y = lax.conv_general_dilated(
        xc, w_conv[:, None, :].astype(xc.dtype), window_strides=(1,),
        padding=[(CONV_K - 1, 0)], dimension_numbers=('NWC', 'WIO', 'NWC'),
        feature_group_count=MIX_WIDTH)
    return b_gate * y


def _spatial_gating_mixer(uv, w_s, b_s, ln_g, ln_b):
    u, v = jnp.split(jax.nn.gelu(uv), 2, axis=-1)
    v = _layer_norm(v, ln_g, ln_b)
    bsz, s, _ = v.shape
    v = v.reshape(bsz, s // GMLP_CHUNK, GMLP_CHUNK, GMLP_GROUPS, MIX_WIDTH // GMLP_GROUPS)
    w_causal = jnp.tril(w_s).astype(v.dtype)
    mixed = jnp.einsum('gts,bcsge->bctge', w_causal, v) + b_s.T[None, None, :, :, None].astype(v.dtype)
    return u * mixed.reshape(bsz, s, MIX_WIDTH)


def _stick_breaking_attention(q, k, v):
    seq = q.shape[2]
    scale = HEAD_DIM ** -0.5
    outs = []
    for i in range(seq // Q_BLOCK):
        start, end = i * Q_BLOCK, (i + 1) * Q_BLOCK
        z = jnp.einsum('bhqd,bhkd->bhqk', q[:, :, start:end], k[:, :, :end]).astype(jnp.float32) * scale
        q_pos = start + jnp.arange(Q_BLOCK)[:, None]
        k_pos = jnp.arange(end)[None, :]
        strict = k_pos < q_pos
        log_1m_beta = jnp.where(strict, jax.nn.log_sigmoid(-z), 0.0)
        later = lax.cumsum(log_1m_beta, axis=3, reverse=True) - log_1m_beta
        w = jnp.where(strict, jnp.exp(jax.nn.log_sigmoid(z) + later), 0.0)
        outs.append(jnp.einsum('bhqk,bhkd->bhqd', w.astype(v.dtype), v[:, :, :end]))
    return jnp.concatenate(outs, axis=2)


def _forgetting_attention(q, k, v, log_f_cum):
    seq = q.shape[2]
    scale = HEAD_DIM ** -0.5
    neg = jnp.finfo(jnp.float32).min
    outs = []
    for i in range(seq // Q_BLOCK):
        start, end = i * Q_BLOCK, (i + 1) * Q_BLOCK
        logits = jnp.einsum('bhqd,bhkd->bhqk', q[:, :, start:end], k[:, :, :end]).astype(jnp.float32) * scale
        logits = logits + log_f_cum[:, :, start:end, None] - log_f_cum[:, :, None, :end]
        causal = jnp.arange(end)[None, :] <= (start + jnp.arange(Q_BLOCK)[:, None])
        p = jax.nn.softmax(jnp.where(causal, logits, neg), axis=-1)
        outs.append(jnp.einsum('bhqk,bhkd->bhqd', p.astype(v.dtype), v[:, :, :end]))
    return jnp.concatenate(outs, axis=2)


def _mixer_block(xn, w_in, w_conv, w_s, b_s, ln_g, ln_b, q_norm_g, k_norm_g, b_f, w_branch, w_out):
    bsz, s, _ = xn.shape
    proj = xn @ w_in
    idx, acc = [], 0
    for size in IN_SPLIT_SIZES[:-1]:
        acc += size
        idx.append(acc)
    (cb, cc, cx, uv, sb_q, sb_k, sb_v, fx_q, fx_k, fx_v, f_raw, gate_raw) = jnp.split(proj, idx, axis=-1)

    y_a = _short_conv_mixer(cb, cc, cx, w_conv)
    y_b = _spatial_gating_mixer(uv, w_s, b_s, ln_g, ln_b)
    y_c = _merge_heads(_stick_breaking_attention(
        _split_heads(sb_q, SB_HEADS), _split_heads(sb_k, SB_HEADS), _split_heads(sb_v, SB_HEADS)))
    fq = _rms_norm(_split_heads(fx_q, FOX_HEADS), q_norm_g)
    fk = _rms_norm(_split_heads(fx_k, FOX_HEADS), k_norm_g)
    log_f = jax.nn.log_sigmoid((f_raw + b_f).astype(jnp.float32)).transpose(0, 2, 1)
    y_d = _merge_heads(_forgetting_attention(fq, fk, _split_heads(fx_v, FOX_HEADS), lax.cumsum(log_f, axis=2)))

    ys = jnp.stack([y_a, y_b, y_c, y_d], axis=2)
    branches = jnp.einsum('bsnc,ncd->bsnd', ys, w_branch)
    gates = jax.nn.sigmoid(gate_raw.reshape(bsz, s, N_BRANCH, D_MODEL).astype(jnp.float32)).astype(xn.dtype)
    merged = jnp.sum(gates * branches, axis=2)
    return merged @ w_out


def _swiglu(x, w_in, w_out):
    g, u = jnp.split(x @ w_in, 2, axis=-1)
    return (jax.nn.silu(g) * u) @ w_out


def setup_inputs(seed: int = 0) -> dict:
    key = jax.random.key(seed)
    ks = jax.random.split(key, 16)
    f32 = jnp.float32
    nrm = lambda k, shape: jax.random.normal(k, shape, f32)
    return {
        'x': nrm(ks[0], (BATCH, SEQ, D_MODEL)),
        'norm_mix_g': 1.0 + 0.05 * nrm(ks[1], (DEPTH, D_MODEL)),
        'w_in': nrm(ks[2], (DEPTH, D_MODEL, N_IN)) * D_MODEL ** -0.5,
        'w_conv': nrm(ks[3], (DEPTH, CONV_K, MIX_WIDTH)) * CONV_K ** -0.5,
        'w_spatial': nrm(ks[4], (DEPTH, GMLP_GROUPS, GMLP_CHUNK, GMLP_CHUNK)) * GMLP_CHUNK ** -0.5,
        'b_spatial': 1.0 + 0.1 * nrm(ks[5], (DEPTH, GMLP_GROUPS, GMLP_CHUNK)),
        'gmlp_ln_g': 1.0 + 0.05 * nrm(ks[6], (DEPTH, MIX_WIDTH)),
        'gmlp_ln_b': 0.02 * nrm(ks[7], (DEPTH, MIX_WIDTH)),
        'fox_q_norm_g': 1.0 + 0.05 * nrm(ks[8], (DEPTH, HEAD_DIM)),
        'fox_k_norm_g': 1.0 + 0.05 * nrm(ks[9], (DEPTH, HEAD_DIM)),
        'fox_forget_b': 2.0 + 0.5 * nrm(ks[10], (DEPTH, FOX_HEADS)),
        'w_branch': nrm(ks[11], (DEPTH, N_BRANCH, MIX_WIDTH, D_MODEL)) * MIX_WIDTH ** -0.5,
        'w_out': nrm(ks[12], (DEPTH, D_MODEL, D_MODEL)) * D_MODEL ** -0.5,
        'norm_ffn_g': 1.0 + 0.05 * nrm(ks[13], (DEPTH, D_MODEL)),
        'w_ffn_in': nrm(ks[14], (DEPTH, D_MODEL, 2 * FFN_HIDDEN)) * D_MODEL ** -0.5,
        'w_ffn_out': nrm(ks[15], (DEPTH, FFN_HIDDEN, D_MODEL)) * FFN_HIDDEN ** -0.5,
    }


def reference(x, norm_mix_g, w_in, w_conv, w_spatial, b_spatial, gmlp_ln_g, gmlp_ln_b,
              fox_q_norm_g, fox_k_norm_g, fox_forget_b, w_branch, w_out, norm_ffn_g,
              w_ffn_in, w_ffn_out):
    h = x
    for l in range(DEPTH):
        xn = _rms_norm(h, norm_mix_g[l])
        h = h + _mixer_block(xn, w_in[l], w_conv[l], w_spatial[l], b_spatial[l], gmlp_ln_g[l],
                             gmlp_ln_b[l], fox_q_norm_g[l], fox_k_norm_g[l], fox_forget_b[l],
                             w_branch[l], w_out[l])
        h = h + _swiglu(_rms_norm(h, norm_ffn_g[l]), w_ffn_in[l], w_ffn_out[l])
    return h
```

```cpp
#include <hip/hip_runtime.h>
#include <cstdint>
#include <cstddef>

namespace {
constexpr int D = 1024, NB = 8, S = 2048, DEPTH = 2, MW = 256, NIN = 6916, FF = 2816, HD = 64;
constexpr int C_CB = 0, C_CC = 256, C_CX = 512, C_U = 768, C_V = 1024, C_SQ = 1280, C_SK = 1536, C_SV = 1792,
              C_FQ = 2048, C_FK = 2304, C_FV = 2560, C_F = 2816, C_G = 2820;

__device__ __forceinline__ float logsig(float x) { return fminf(x, 0.f) - log1pf(expf(-fabsf(x))); }
__device__ __forceinline__ float gelu_tanh(float x) { return 0.5f * x * (1.f + tanhf(0.7978845608028654f * (x + 0.044715f * x * x * x))); }

__global__ void __launch_bounds__(256) rmsnorm_k(const float* in, const float* g, float* out) {
    const int row = blockIdx.x, tid = threadIdx.x;
    const float* x = in + (size_t)row * D;
    float v0 = x[tid], v1 = x[tid + 256], v2 = x[tid + 512], v3 = x[tid + 768];
    float s = v0 * v0 + v1 * v1 + v2 * v2 + v3 * v3;
    __shared__ float red[256];
    red[tid] = s; __syncthreads();
    for (int o = 128; o > 0; o >>= 1) { if (tid < o) red[tid] += red[tid + o]; __syncthreads(); }
    const float r = rsqrtf(red[0] * (1.f / D) + 1e-6f);
    float* o = out + (size_t)row * D;
    o[tid] = v0 * r * g[tid]; o[tid + 256] = v1 * r * g[tid + 256]; o[tid + 512] = v2 * r * g[tid + 512]; o[tid + 768] = v3 * r * g[tid + 768];
}

template <int MODE>
__global__ void __launch_bounds__(256) gemm_k(const float* A, int lda, const float* Bm, int ldb, float* C, int ldc, int N, int K, const float* G, int ldg) {
    __shared__ float As[16][65];
    __shared__ float Bs[16][65];
    const int tid = threadIdx.x, tx = tid & 15, ty = tid >> 4;
    const int m0 = blockIdx.y * 64, n0 = blockIdx.x * 64;
    float acc[4][4];
#pragma unroll
    for (int i = 0; i < 4; ++i)
#pragma unroll
        for (int j = 0; j < 4; ++j) acc[i][j] = 0.f;
    for (int k0 = 0; k0 < K; k0 += 16) {
#pragma unroll
        for (int i = 0; i < 4; ++i) {
            const int idx = tid + 256 * i;
            { const int r = idx >> 4, kk = idx & 15; As[kk][r] = A[(size_t)(m0 + r) * lda + k0 + kk]; }
            { const int kk = idx >> 6, c = idx & 63; Bs[kk][c] = (n0 + c < N) ? Bm[(size_t)(k0 + kk) * ldb + n0 + c] : 0.f; }
        }
        __syncthreads();
#pragma unroll
        for (int kk = 0; kk < 16; ++kk) {
            float a[4], b[4];
#pragma unroll
            for (int i = 0; i < 4; ++i) { a[i] = As[kk][ty * 4 + i]; b[i] = Bs[kk][tx * 4 + i]; }
#pragma unroll
            for (int i = 0; i < 4; ++i)
#pragma unroll
                for (int j = 0; j < 4; ++j) acc[i][j] = fmaf(a[i], b[j], acc[i][j]);
        }
        __syncthreads();
    }
#pragma unroll
    for (int i = 0; i < 4; ++i)
#pragma unroll
        for (int j = 0; j < 4; ++j) {
            const int r = m0 + ty * 4 + i, c = n0 + tx * 4 + j;
            if (c < N) {
                float v = acc[i][j];
                if (MODE >= 2) { const float gr = G[(size_t)r * ldg + c]; v *= 1.f / (1.f + expf(-gr)); }
                float* p = C + (size_t)r * ldc + c;
                if (MODE == 1 || MODE == 3) *p += v; else *p = v;
            }
        }
}

__global__ void __launch_bounds__(256) conv_k(const float* proj, const float* wc, float* ys) {
    const int t = blockIdx.x, c = threadIdx.x;
    float acc = 0.f;
#pragma unroll
    for (int k = 0; k < 3; ++k) {
        const int tt = t - 2 + k;
        if (tt >= 0) { const float* p = proj + (size_t)tt * NIN; acc += wc[k * MW + c] * (p[C_CC + c] * p[C_CX + c]); }
    }
    ys[(size_t)t * D + c] = proj[(size_t)t * NIN + C_CB + c] * acc;
}

__global__ void __launch_bounds__(256) gm1_k(const float* proj, const float* lng, const float* lnb, float* U, float* VH) {
    const int t = blockIdx.x, c = threadIdx.x;
    const float* p = proj + (size_t)t * NIN;
    const float u = gelu_tanh(p[C_U + c]), v = gelu_tanh(p[C_V + c]);
    __shared__ float red[256];
    red[c] = v; __syncthreads();
    for (int o = 128; o > 0; o >>= 1) { if (c < o) red[c] += red[c + o]; __syncthreads(); }
    const float mu = red[0] * (1.f / 256.f); __syncthreads();
    const float dv = v - mu;
    red[c] = dv * dv; __syncthreads();
    for (int o = 128; o > 0; o >>= 1) { if (c < o) red[c] += red[c + o]; __syncthreads(); }
    const float var = red[0] * (1.f / 256.f);
    U[(size_t)t * MW + c] = u;
    VH[(size_t)t * MW + c] = dv * rsqrtf(var + 1e-6f) * lng[c] + lnb[c];
}
__global__ void __launch_bounds__(256) gm2_k(const float* U, const float* VH, const float* ws_, const float* bs_, float* ys) {
    const int t = blockIdx.x, c = threadIdx.x, g = c >> 6, tl = t & 127, base = t - tl;
    const float* w = ws_ + ((size_t)g * 128 + tl) * 128;
    float acc = 0.f;
    for (int s = 0; s <= tl; ++s) acc = fmaf(w[s], VH[(size_t)(base + s) * MW + c], acc);
    ys[(size_t)t * D + 256 + c] = U[(size_t)t * MW + c] * (acc + bs_[g * 128 + tl]);
}

__global__ void __launch_bounds__(64) sb_k(const float* proj, float* ys) {
    const int h = blockIdx.y, t = blockIdx.x * 64 + threadIdx.x, smax = blockIdx.x * 64 + 63;
    float q[HD];
    const float* qp = proj + (size_t)t * NIN + C_SQ + h * HD;
#pragma unroll
    for (int d = 0; d < HD; ++d) q[d] = qp[d];
    float total = 0.f;
    for (int s = 0; s < smax; ++s) {
        const float* kp = proj + (size_t)s * NIN + C_SK + h * HD;
        float z = 0.f;
#pragma unroll
        for (int d = 0; d < HD; ++d) z = fmaf(q[d], kp[d], z);
        z *= 0.125f;
        if (s < t) total += logsig(-z);
    }
    float acc[HD];
#pragma unroll
    for (int d = 0; d < HD; ++d) acc[d] = 0.f;
    float prefix = 0.f;
    for (int s = 0; s < smax; ++s) {
        const float* kp = proj + (size_t)s * NIN + C_SK + h * HD;
        const float* vp = proj + (size_t)s * NIN + C_SV + h * HD;
        float z = 0.f;
#pragma unroll
        for (int d = 0; d < HD; ++d) z = fmaf(q[d], kp[d], z);
        z *= 0.125f;
        float w = 0.f;
        if (s < t) { prefix += logsig(-z); w = expf(logsig(z) + (total - prefix)); }
#pragma unroll
        for (int d = 0; d < HD; ++d) acc[d] = fmaf(w, vp[d], acc[d]);
    }
    float* o = ys + (size_t)t * D + 512 + h * HD;
#pragma unroll
    for (int d = 0; d < HD; ++d) o[d] = acc[d];
}

__global__ void __launch_bounds__(256) qknorm_k(const float* proj, const float* gq, const float* gk, float* QH, float* KH) {
    const int t = blockIdx.x, c = threadIdx.x, d = c & 63;
    const float* p = proj + (size_t)t * NIN;
    const float q = p[C_FQ + c], k = p[C_FK + c];
    float sq = q * q, sk = k * k;
#pragma unroll
    for (int o = 1; o < 64; o <<= 1) { sq += __shfl_xor(sq, o); sk += __shfl_xor(sk, o); }
    QH[(size_t)t * MW + c] = q * rsqrtf(sq * (1.f / 64.f) + 1e-6f) * gq[d];
    KH[(size_t)t * MW + c] = k * rsqrtf(sk * (1.f / 64.f) + 1e-6f) * gk[d];
}
__global__ void cum_k(const float* proj, const float* bf, float* Cc) {
    const int h = threadIdx.x;
    if (h >= 4) return;
    float run = 0.f;
    for (int t = 0; t < S; ++t) { run += logsig(proj[(size_t)t * NIN + C_F + h] + bf[h]); Cc[h * S + t] = run; }
}
__global__ void __launch_bounds__(64) fox_k(const float* proj, const float* QH, const float* KH, const float* Cc, float* ys) {
    const int h = blockIdx.y, t = blockIdx.x * 64 + threadIdx.x, smax = blockIdx.x * 64 + 63;
    float q[HD];
#pragma unroll
    for (int d = 0; d < HD; ++d) q[d] = QH[(size_t)t * MW + h * HD + d];
    const float ct = Cc[h * S + t];
    float m = -3.0e38f, l = 0.f;
    float acc[HD];
#pragma unroll
    for (int d = 0; d < HD; ++d) acc[d] = 0.f;
    for (int s = 0; s <= smax; ++s) {
        const float* kp = KH + (size_t)s * MW + h * HD;
        const float* vp = proj + (size_t)s * NIN + C_FV + h * HD;
        float z = 0.f;
#pragma unroll
        for (int d = 0; d < HD; ++d) z = fmaf(q[d], kp[d], z);
        z = z * 0.125f + ct - Cc[h * S + s];
        if (s <= t) {
            const float mn = fmaxf(m, z), f = expf(m - mn), p = expf(z - mn);
            l = l * f + p;
#pragma unroll
            for (int d = 0; d < HD; ++d) acc[d] = fmaf(p, vp[d], acc[d] * f);
            m = mn;
        }
    }
    const float inv = 1.f / l;
    float* o = ys + (size_t)t * D + 768 + h * HD;
#pragma unroll
    for (int d = 0; d < HD; ++d) o[d] = acc[d] * inv;
}
__global__ void __launch_bounds__(256) swiglu_k(const float* mid, float* hid) {
    const int t = blockIdx.y, j = blockIdx.x * 256 + threadIdx.x;
    const float g = mid[(size_t)t * (2 * FF) + j], u = mid[(size_t)t * (2 * FF) + FF + j];
    hid[(size_t)t * FF + j] = g / (1.f + expf(-g)) * u;
}
}

extern "C" void kernel_launch(void* const* d_in, const int* in_sizes, int n_in, void* d_out, int out_size, void* d_ws, size_t ws_size, hipStream_t stream) {
    const float* x = (const float*)d_in[0];
    const float* norm_mix_g = (const float*)d_in[1];
    const float* w_in = (const float*)d_in[2];
    const float* w_conv = (const float*)d_in[3];
    const float* w_spatial = (const float*)d_in[4];
    const float* b_spatial = (const float*)d_in[5];
    const float* ln_g = (const float*)d_in[6];
    const float* ln_b = (const float*)d_in[7];
    const float* gq = (const float*)d_in[8];
    const float* gk = (const float*)d_in[9];
    const float* bf = (const float*)d_in[10];
    const float* w_branch = (const float*)d_in[11];
    const float* w_out = (const float*)d_in[12];
    const float* norm_ffn_g = (const float*)d_in[13];
    const float* w_ffn_in = (const float*)d_in[14];
    const float* w_ffn_out = (const float*)d_in[15];
    float* h = (float*)d_out;
    float* ws = (float*)d_ws;
    float* proj = ws;
    float* xn = proj + (size_t)S * NIN;
    float* ys = xn + (size_t)S * D;
    float* merged = ys + (size_t)S * D;
    float* mid = merged + (size_t)S * D;
    float* hid = mid + (size_t)S * 2 * FF;
    float* U = hid + (size_t)S * FF;
    float* VH = U + (size_t)S * MW;
    float* QH = VH + (size_t)S * MW;
    float* KH = QH + (size_t)S * MW;
    float* Cc = KH + (size_t)S * MW;
    hipMemcpyAsync(h, x, (size_t)NB * S * D * sizeof(float), hipMemcpyDeviceToDevice, stream);
    for (int l = 0; l < DEPTH; ++l) {
        const float* Win = w_in + (size_t)l * D * NIN;
        for (int b = 0; b < NB; ++b) {
            float* hb = h + (size_t)b * S * D;
            rmsnorm_k<<<S, 256, 0, stream>>>(hb, norm_mix_g + l * D, xn);
            gemm_k<0><<<dim3((NIN + 63) / 64, S / 64), 256, 0, stream>>>(xn, D, Win, NIN, proj, NIN, NIN, D, nullptr, 0);
            conv_k<<<S, 256, 0, stream>>>(proj, w_conv + l * 3 * MW, ys);
            gm1_k<<<S, 256, 0, stream>>>(proj, ln_g + l * MW, ln_b + l * MW, U, VH);
            gm2_k<<<S, 256, 0, stream>>>(U, VH, w_spatial + (size_t)l * 4 * 128 * 128, b_spatial + l * 4 * 128, ys);
            sb_k<<<dim3(S / 64, 4), 64, 0, stream>>>(proj, ys);
            qknorm_k<<<S, 256, 0, stream>>>(proj, gq + l * HD, gk + l * HD, QH, KH);
            cum_k<<<1, 64, 0, stream>>>(proj, bf + l * 4, Cc);
            fox_k<<<dim3(S / 64, 4), 64, 0, stream>>>(proj, QH, KH, Cc, ys);
            for (int n = 0; n < 4; ++n) {
                const float* Wb = w_branch + ((size_t)l * 4 + n) * MW * D;
                if (n == 0) gemm_k<2><<<dim3(D / 64, S / 64), 256, 0, stream>>>(ys + n * MW, D, Wb, D, merged, D, D, MW, proj + C_G + n * D, NIN);
                else        gemm_k<3><<<dim3(D / 64, S / 64), 256, 0, stream>>>(ys + n * MW, D, Wb, D, merged, D, D, MW, proj + C_G + n * D, NIN);
            }
            gemm_k<1><<<dim3(D / 64, S / 64), 256, 0, stream>>>(merged, D, w_out + (size_t)l * D * D, D, hb, D, D, D, nullptr, 0);
            rmsnorm_k<<<S, 256, 0, stream>>>(hb, norm_ffn_g + l * D, xn);
            gemm_k<0><<<dim3(2 * FF / 64, S / 64), 256, 0, stream>>>(xn, D, w_ffn_in + (size_t)l * D * 2 * FF, 2 * FF, mid, 2 * FF, 2 * FF, D, nullptr, 0);
            swiglu_k<<<dim3(FF / 256, S), 256, 0, stream>>>(mid, hid);
            gemm_k<1><<<dim3(D / 64, S / 64), 256, 0, stream>>>(hid, FF, w_ffn_out + (size_t)l * FF * D, D, hb, D, D, FF, nullptr, 0);
        }
    }
}
```

```cpp
#include <hip/hip_runtime.h>
#include <hip/hip_bf16.h>
#include <cstdio>
#include <cstdint>
#include <cstddef>

#define LAS __attribute__((address_space(3)))
#define GAS __attribute__((address_space(1)))
typedef unsigned short bf16_t;
typedef short bf16x8 __attribute__((ext_vector_type(8)));
typedef short s16x4 __attribute__((ext_vector_type(4)));
typedef float f32x4 __attribute__((ext_vector_type(4)));
typedef float f32x2 __attribute__((ext_vector_type(2)));
typedef float f32x16 __attribute__((ext_vector_type(16)));
typedef unsigned u32x4 __attribute__((ext_vector_type(4)));
typedef unsigned u32x2 __attribute__((ext_vector_type(2)));

constexpr int DM = 1024, NBATCH = 8, SEQ = 2048, M = NBATCH * SEQ, DEPTH = 2, NIN = 6916, FF = 2816;
constexpr int NP1 = 28 * 256;
constexpr int NF1 = 2 * FF;
constexpr int PA = 2048, PB = 768, PG = 4096;
constexpr int A_YA = 0  , A_YB = 256  , A_YC = 512  , A_YD = 768  , A_CC = 1024, A_CX = 1280, A_V = 1536, A_SK = 1792, A_MRG = 1024  ;
constexpr int B_SV = 0, B_FK = 256, B_FV = 512;
constexpr float LOG2E = 1.4426950408889634f;
constexpr float QSCALE = 0.125f * LOG2E;
constexpr float EPS = 1e-6f;

constexpr size_t MiB = 1u << 20;
constexpr size_t WS_CTL = 0, CTL_ZERO_BYTES = 1 * MiB;
constexpr size_t WS_WIN = 1 * MiB, WS_WBR = 15 * MiB, WS_WOUT = 17 * MiB, WS_WF1 = 19 * MiB, WS_WF2 = 30 * MiB;
constexpr size_t WS_PART = 36 * MiB, WS_LOGF = 37 * MiB, WS_HB = 38 * MiB, WS_LO = 70 * MiB, WS_MB = 102 * MiB, WS_GATES = 126 * MiB, WS_END = 254 * MiB;
static_assert(WS_WIN + (size_t)NP1 * DM * 2 <= WS_WBR && WS_WF1 + (size_t)NF1 * DM * 2 <= WS_WF2 && WS_WF2 + (size_t)DM * FF * 2 <= WS_PART, "weights map");
static_assert(WS_MB + (size_t)M * PB * 2 <= WS_GATES && WS_GATES + (size_t)M * PG * 2 <= WS_END && (size_t)M * FF * 2 <= (size_t)M * PG * 2, "activation map");
constexpr int CW_TMO = 0, CW_CODE = 1, CW_BAR = 4096, CW_QUEUE = 8192;

constexpr int RING_BYTES = 131072, LDSCTL_OFF = RING_BYTES, MISC_OFF = LDSCTL_OFF + 320, LDS_BYTES = 147456;
constexpr int NWAVES = 8;

__device__ __forceinline__ unsigned cvt_pk_bf16(float lo, float hi) { typedef __bf16 bf2 __attribute__((ext_vector_type(2))); f32x2 v = {lo, hi}; bf2 b = __builtin_convertvector(v, bf2); return __builtin_bit_cast(unsigned, b); }
__device__ __forceinline__ float bf_lo(unsigned w) { return __uint_as_float(w << 16); }
__device__ __forceinline__ float bf_hi(unsigned w) { return __uint_as_float(w & 0xffff0000u); }
__device__ __forceinline__ float fast_sigmoid(float x) { return __builtin_amdgcn_rcpf(1.f + __builtin_amdgcn_exp2f(-LOG2E * x)); }
__device__ __forceinline__ float gelu_tanh_f(float x) { const float t = x * (1.f + 0.044715f * x * x); return x * __builtin_amdgcn_rcpf(1.f + __builtin_amdgcn_exp2f(-2.302208198f * t)); }
__device__ __forceinline__ float logsig_f(float x) { return fminf(x, 0.f) - log1pf(expf(-fabsf(x))); }
#define LDS_WAIT() asm volatile("s_waitcnt lgkmcnt(0)" ::: "memory")
#define VM_WAIT() asm volatile("s_waitcnt vmcnt(0)" ::: "memory")
#define OPQ_V(x) asm volatile("" : "+v"(x))
#define OPQ_S(x) asm volatile("" : "+s"(x))
struct Args { const float* in[16]; float* out; unsigned char* ws; int ph_lo, ph_hi; };
typedef const __attribute__((address_space(4))) Args* kargs_t;
__device__ __forceinline__ kargs_t kargs() { kargs_t p = (kargs_t)__builtin_amdgcn_kernarg_segment_ptr(); OPQ_S(p); return p; }
__device__ __forceinline__ int opaque_tid() { int t = threadIdx.x; OPQ_V(t); return t; }

namespace pg8 {
constexpr int BM = 256, BK = 64, HALF = 128, HTB = HALF * BK * 2, STAGE_BYTES = 8 * HTB, NXCD = 8, WGM = 8;
__host__ __device__ __forceinline__ int lds_byte(int r, int c) { const int st = (r >> 4) * 2 + (c >> 5), rr = r & 15, cc = c & 31, ob = rr * 64 + cc * 2; return st * 1024 + (ob ^ (((ob >> 9) & 1) << 5)); }
__host__ __device__ __forceinline__ void stage_rc(int b, int& R, int& C) { const int st = b / 1024, sb = b % 1024, swz = sb ^ (((sb >> 9) & 1) << 5); R = (st >> 1) * 16 + swz / 64; C = (st & 1) * 32 + (swz % 64) / 2; }
__host__ __device__ __forceinline__ int perm32(int rho) { const int n = rho >> 4, i = rho & 15; return 8 * (i >> 2) + 4 * n + (i & 3); }

struct Unit { int pm, pn, z; };
struct Gemm { const bf16_t* A; const bf16_t* Bt; int lda, K; size_t azs, bzs; };

struct StaticOrder {
    int nM, nN, nwg, G, c;
    __host__ __device__ void init(int M_, int N_, int G_, int c_) { nM = M_ / BM; nN = N_ / BM; nwg = nM * nN; G = G_; c = c_; }
    __host__ __device__ bool next(int i, Unit& u) const {
        const long L = (long)i * G + c; if (L >= nwg) return false;
        int wgid = (int)L; { const int q = nwg / NXCD, r = nwg % NXCD, xcd = wgid % NXCD, off = wgid / NXCD; wgid = (xcd < r ? xcd * (q + 1) : r * (q + 1) + (xcd - r) * q) + off; }
        const int nig = WGM * nN, gid = wgid / nig, fm = gid * WGM, gsz = (nM - fm) < WGM ? (nM - fm) : WGM;
        u.pm = fm + ((wgid % nig) % gsz); u.pn = (wgid % nig) / gsz; u.z = 0; return true;
    }
};
struct BranchOrder {
    StaticOrder s;
    __host__ __device__ bool next(int i, Unit& u) const { if (i >= 4) return false; if (!s.next(0, u)) return false; u.z = i; return true; }
};

template <class Epi, class Sched>
__device__ __forceinline__ void gemm_phase(LAS unsigned char* lds, const Gemm g, const Sched& S, const Epi& E) {
    const int tid = opaque_tid(), wid = __builtin_amdgcn_readfirstlane(tid >> 6), lane = tid & 63, wr = wid >> 2, wc = wid & 3, fr = lane & 15, fq = lane >> 4;
    const int K = g.K, nt = K / BK;
    unsigned voffA[2], voffB[2];
#pragma unroll
    for (int i = 0; i < 2; ++i) { int R, C; stage_rc(tid * 16 + i * 8192, R, C); const int Rb = (R & ~31) + perm32(R & 31);
        voffA[i] = (unsigned)(R * g.lda + C) * 2u; voffB[i] = (unsigned)(Rb * K + C) * 2u; }
    const size_t kstep = (size_t)(BK * 2);
    const size_t hstepA = (size_t)HALF * g.lda * 2, tstepA = 2 * hstepA;
    const size_t hstepB = (size_t)HALF * K * 2, tstepB = 2 * hstepB;
    const unsigned ldsw = (unsigned)wid * 1024u;
    const int aoff = lds_byte(wr * 64 + fr, fq * 8), boff = lds_byte(wc * 32 + fr, fq * 8);
#define PG8_SA(b, h) (((b) * 2 + (h)) * HTB)
#define PG8_SB(b, h) ((4 + (b) * 2 + (h)) * HTB)
#define PG8_STAGE(bufoff, gbase, voff) do { _Pragma("unroll") for (int _i = 0; _i < 2; ++_i) \
        __builtin_amdgcn_global_load_lds((const unsigned*)((const char*)(gbase) + (voff)[_i]), (LAS unsigned*)(lds + (bufoff) + ldsw + _i * 8192), 16, 0, 0); } while (0)
#define PG8_LDA(dst, b, h) do { _Pragma("unroll") for (int m = 0; m < 4; ++m) _Pragma("unroll") for (int k = 0; k < 2; ++k) dst[m][k] = *(const LAS bf16x8*)(lds + PG8_SA(b, h) + aoff + m * 2048 + k * 1024); } while (0)
#define PG8_LDB(dst, b, h) do { _Pragma("unroll") for (int n = 0; n < 2; ++n) _Pragma("unroll") for (int k = 0; k < 2; ++k) dst[n][k] = *(const LAS bf16x8*)(lds + PG8_SB(b, h) + boff + n * 2048 + k * 1024); } while (0)
#define PG8_MMA(ai, bj, At, Bt) do { __builtin_amdgcn_s_setprio(1); _Pragma("unroll") for (int m = 0; m < 4; ++m) _Pragma("unroll") for (int n = 0; n < 2; ++n) _Pragma("unroll") for (int k = 0; k < 2; ++k) \
        acc[ai][bj][m][n] = __builtin_amdgcn_mfma_f32_16x16x32_bf16(Bt[n][k], At[m][k], acc[ai][bj][m][n], 0, 0, 0); __builtin_amdgcn_s_setprio(0); } while (0)
#define PG8_WAIT_V(n) asm volatile("s_waitcnt vmcnt(" #n ")" ::: "memory")
#define PG8_WAIT_L(n) asm volatile("s_waitcnt lgkmcnt(" #n ")" ::: "memory")
#define PG8_BAR __builtin_amdgcn_s_barrier()
#define PG8_SCHED __builtin_amdgcn_sched_barrier(0)
    Unit cur, nxt; int ui = 0;
    if (!S.next(0, cur)) return;
    f32x4 acc[2][2][4][2];
#pragma unroll
    for (int a = 0; a < 2; ++a)
#pragma unroll
        for (int b = 0; b < 2; ++b)
#pragma unroll
            for (int m = 0; m < 4; ++m)
#pragma unroll
                for (int n = 0; n < 2; ++n) acc[a][b][m][n] = (f32x4){0.f, 0.f, 0.f, 0.f};
    bf16x8 At[4][2], B0[2][2], B1[2][2];
    const char* cA = (const char*)g.A + (size_t)cur.pm * tstepA + (size_t)cur.z * g.azs * 2; const char* cB = (const char*)g.Bt + (size_t)cur.pn * tstepB + (size_t)cur.z * g.bzs * 2;
    PG8_STAGE(PG8_SB(0, 0), cB, voffB); PG8_STAGE(PG8_SB(0, 1), cB + hstepB, voffB); PG8_STAGE(PG8_SA(0, 0), cA, voffA); PG8_STAGE(PG8_SA(0, 1), cA + hstepA, voffA);
    if (wr == 1) PG8_BAR;
    PG8_WAIT_V(2); PG8_BAR;
    PG8_STAGE(PG8_SB(1, 0), cB + kstep, voffB); PG8_STAGE(PG8_SA(1, 0), cA + kstep, voffA); PG8_STAGE(PG8_SB(1, 1), cB + hstepB + kstep, voffB);
    PG8_WAIT_V(6); PG8_BAR;
    for (;;) {
        const bool has_next = S.next(ui + 1, nxt);
        const char* nA = has_next ? (const char*)g.A + (size_t)nxt.pm * tstepA + (size_t)nxt.z * g.azs * 2 : cA;
        const char* nB = has_next ? (const char*)g.Bt + (size_t)nxt.pn * tstepB + (size_t)nxt.z * g.bzs * 2 : cB;
        for (int t = 0; t < nt; t += 2) {
            const bool last = (t == nt - 2);
            const char* a1 = cA + (size_t)(t + 1) * kstep;
            const char* a2 = last ? nA : cA + (size_t)(t + 2) * kstep; const char* b2 = last ? nB : cB + (size_t)(t + 2) * kstep;
            const char* a3 = a2 + kstep; const char* b3 = b2 + kstep;
            PG8_LDB(B0, 0, 0); PG8_LDB(B1, 0, 1); PG8_SCHED; PG8_LDA(At, 0, 0); PG8_STAGE(PG8_SA(1, 1), a1 + hstepA, voffA);
            PG8_WAIT_V(8); PG8_WAIT_L(0); PG8_BAR; PG8_MMA(0, 0, At, B0); PG8_MMA(0, 1, At, B1); PG8_BAR; PG8_SCHED;
            PG8_LDA(At, 0, 1); PG8_STAGE(PG8_SB(0, 0), b2, voffB); PG8_STAGE(PG8_SB(0, 1), b2 + hstepB, voffB); PG8_STAGE(PG8_SA(0, 0), a2, voffA);
            PG8_WAIT_V(8); PG8_WAIT_L(0); PG8_BAR; PG8_MMA(1, 0, At, B0); PG8_MMA(1, 1, At, B1); PG8_BAR; PG8_SCHED;
            PG8_LDB(B0, 1, 0); PG8_LDB(B1, 1, 1); PG8_SCHED; PG8_LDA(At, 1, 0); PG8_STAGE(PG8_SA(0, 1), a2 + hstepA, voffA);
            PG8_WAIT_V(8); PG8_WAIT_L(0); PG8_BAR; PG8_MMA(0, 0, At, B0); PG8_MMA(0, 1, At, B1); PG8_BAR; PG8_SCHED;
            PG8_LDA(At, 1, 1); PG8_STAGE(PG8_SB(1, 0), b3, voffB); PG8_STAGE(PG8_SB(1, 1), b3 + hstepB, voffB); PG8_STAGE(PG8_SA(1, 0), a3, voffA);
            PG8_WAIT_V(8); PG8_WAIT_L(0); PG8_BAR; PG8_MMA(1, 0, At, B0); PG8_MMA(1, 1, At, B1); PG8_BAR; PG8_SCHED;
        }
        if (wr == 0) PG8_BAR;
        E(acc, cur, wr, wc, fr, fq);
        if (!has_next) break;
#pragma unroll
        for (int a = 0; a < 2; ++a)
#pragma unroll
            for (int b = 0; b < 2; ++b)
#pragma unroll
                for (int m = 0; m < 4; ++m)
#pragma unroll
                    for (int n = 0; n < 2; ++n) acc[a][b][m][n] = (f32x4){0.f, 0.f, 0.f, 0.f};
        cur = nxt; cA = nA; cB = nB; ++ui;
        if (wr == 1) PG8_BAR;
    }
    PG8_WAIT_V(0);
    PG8_BAR;
#undef PG8_SA
#undef PG8_SB
#undef PG8_STAGE
#undef PG8_LDA
#undef PG8_LDB
#undef PG8_MMA
#undef PG8_WAIT_V
#undef PG8_WAIT_L
#undef PG8_BAR
#undef PG8_SCHED
}

__device__ __forceinline__ u32x4 pack8(const f32x4& v0, const f32x4& v1) { u32x4 w; w.x = cvt_pk_bf16(v0[0], v0[1]); w.y = cvt_pk_bf16(v0[2], v0[3]); w.z = cvt_pk_bf16(v1[0], v1[1]); w.w = cvt_pk_bf16(v1[2], v1[3]); return w; }
__device__ __forceinline__ float row_rstd(const float* part, int row) {
    const f32x4* p = (const f32x4*)(part + (size_t)row * 16); const f32x4 a = p[0], b = p[1], c = p[2], d = p[3];
    const float s = ((a[0] + a[1]) + (a[2] + a[3])) + ((b[0] + b[1]) + (b[2] + b[3])) + ((c[0] + c[1]) + (c[2] + c[3])) + ((d[0] + d[1]) + (d[2] + d[3]));
    return rsqrtf(s * (1.f / DM) + EPS);
}

#define EPI_LANE() const int tid_ = opaque_tid(); const int wid_ = __builtin_amdgcn_readfirstlane(tid_ >> 6), lane_ = tid_ & 63, wr = wid_ >> 2, wc = wid_ & 3, fr = lane_ & 15, fq = lane_ >> 4; (void)wr; (void)wc; (void)fr; (void)fq
struct EpiP1 {
    int l;
    __device__ __forceinline__ void operator()(const f32x4 (&acc)[2][2][4][2], const Unit& u, int, int, int, int) const {
        EPI_LANE();
        const kargs_t ka = kargs(); unsigned char* ws = ka->ws; bf16_t* mainA = (bf16_t*)ka->out; bf16_t* mainB = (bf16_t*)(ws + WS_MB); const float* part = (const float*)(ws + WS_PART);
        const int pn = u.pn, row0 = u.pm * BM + wr * 64 + fr;
        const int ch0 = 64 * wc + 8 * fq;
        if (pn == 27) {
            if (wc == 0 && fq == 0) {
                float* lgf = (float*)(ws + WS_LOGF);
                const f32x4 bb = *(const f32x4*)(ka->in[10] + l * 4);
#pragma unroll
                for (int ai = 0; ai < 2; ++ai)
#pragma unroll
                    for (int m = 0; m < 4; ++m) { const int row = row0 + ai * HALF + m * 16; const f32x4 v = acc[ai][0][m][0] * row_rstd(part, row); f32x4 o;
                        o[0] = logsig_f(v[0] + bb[0]); o[1] = logsig_f(v[1] + bb[1]); o[2] = logsig_f(v[2] + bb[2]); o[3] = logsig_f(v[3] + bb[3]);
                        *(f32x4*)(lgf + (size_t)row * 4) = o; }
            }
            return;
        }
        if (pn == 8 || pn == 9) {
            bf16_t* dst = (pn == 8) ? mainA + A_YD : mainB + B_FK; const int pitch = (pn == 8) ? PA : PB;
            f32x4 gm[2][2];
#pragma unroll
            for (int bj = 0; bj < 2; ++bj)
#pragma unroll
                for (int n = 0; n < 2; ++n) { const int d = 32 * bj + 8 * fq + 4 * n;
                    if (pn == 8) { const f32x4 a = *(const f32x4*)(ka->in[8] + l * 64 + d), b = *(const f32x4*)(ka->in[9] + l * 64 + d); gm[bj][n] = a * b * QSCALE; } else gm[bj][n] = (f32x4){1.f, 1.f, 1.f, 1.f}; }
#pragma unroll
            for (int ai = 0; ai < 2; ++ai)
#pragma unroll
                for (int m = 0; m < 4; ++m) { const int row = row0 + ai * HALF + m * 16; const float r = row_rstd(part, row); float ss = 0.f; f32x4 v[2][2];
#pragma unroll
                    for (int bj = 0; bj < 2; ++bj)
#pragma unroll
                        for (int n = 0; n < 2; ++n) { v[bj][n] = acc[ai][bj][m][n] * r; const f32x4 q = v[bj][n] * v[bj][n]; ss += (q[0] + q[1]) + (q[2] + q[3]); }
                    ss += __shfl_xor(ss, 16); ss += __shfl_xor(ss, 32);
                    const float rn = rsqrtf(ss * (1.f / 64.f) + EPS);
                    bf16_t* rowp = dst + (size_t)row * pitch + ch0;
#pragma unroll
                    for (int bj = 0; bj < 2; ++bj) *(u32x4*)(rowp + 32 * bj) = pack8(v[bj][0] * rn * gm[bj][0], v[bj][1] * rn * gm[bj][1]); }
            return;
        }
        bf16_t* dst; int pitch; int mode = 0; float sc = 1.f;
        if (pn >= 11) { dst = (bf16_t*)(ws + WS_GATES) + 256 * (pn - 11); pitch = PG; mode = 2; }
        else if (pn == 0) { dst = mainA + A_YA; pitch = PA; }
        else if (pn == 1) { dst = mainA + A_CC; pitch = PA; }
        else if (pn == 2) { dst = mainA + A_CX; pitch = PA; }
        else if (pn == 3) { dst = mainA + A_YB; pitch = PA; mode = 1; }
        else if (pn == 4) { dst = mainA + A_V; pitch = PA; mode = 1; }
        else if (pn == 5) { dst = mainA + A_YC; pitch = PA; sc = QSCALE; }
        else if (pn == 6) { dst = mainA + A_SK; pitch = PA; }
        else if (pn == 7) { dst = mainB + B_SV; pitch = PB; }
        else { dst = mainB + B_FV; pitch = PB; }
#pragma unroll
        for (int ai = 0; ai < 2; ++ai)
#pragma unroll
            for (int m = 0; m < 4; ++m) { const int row = row0 + ai * HALF + m * 16; const float r = row_rstd(part, row) * sc; bf16_t* rowp = dst + (size_t)row * pitch + ch0;
#pragma unroll
                for (int bj = 0; bj < 2; ++bj) { f32x4 v0 = acc[ai][bj][m][0] * r, v1 = acc[ai][bj][m][1] * r;
                    if (mode == 1) {
#pragma unroll
                        for (int e = 0; e < 4; ++e) { v0[e] = gelu_tanh_f(v0[e]); v1[e] = gelu_tanh_f(v1[e]); } }
                    else if (mode == 2) {
#pragma unroll
                        for (int e = 0; e < 4; ++e) { v0[e] = fast_sigmoid(v0[e]); v1[e] = fast_sigmoid(v1[e]); } }
                    *(u32x4*)(rowp + 32 * bj) = pack8(v0, v1); } }
    }
};
struct EpiBranch {
    int dummy;
    __device__ __forceinline__ void operator()(const f32x4 (&acc)[2][2][4][2], const Unit& u, int, int, int, int) const {
        EPI_LANE();
        const kargs_t ka = kargs(); const bf16_t* gates = (const bf16_t*)(ka->ws + WS_GATES); bf16_t* merged = (bf16_t*)ka->out + A_MRG;
        const int row0 = u.pm * BM + wr * 64 + fr, col0 = u.pn * BM + wc * 32 + 8 * fq;
#pragma unroll
        for (int ai = 0; ai < 2; ++ai)
#pragma unroll
            for (int m = 0; m < 4; ++m) { const size_t row = (size_t)(row0 + ai * HALF + m * 16);
#pragma unroll
                for (int bj = 0; bj < 2; ++bj) { const int c = col0 + bj * HALF;
                    const u32x4 gw = *(const u32x4*)(gates + row * PG + u.z * DM + c);
                    f32x4 v0 = acc[ai][bj][m][0], v1 = acc[ai][bj][m][1];
                    v0[0] *= bf_lo(gw.x); v0[1] *= bf_hi(gw.x); v0[2] *= bf_lo(gw.y); v0[3] *= bf_hi(gw.y);
                    v1[0] *= bf_lo(gw.z); v1[1] *= bf_hi(gw.z); v1[2] *= bf_lo(gw.w); v1[3] *= bf_hi(gw.w);
                    bf16_t* p = merged + row * PA + c;
                    if (u.z != 0) { const u32x4 ow = *(const u32x4*)p;
                        v0[0] += bf_lo(ow.x); v0[1] += bf_hi(ow.x); v0[2] += bf_lo(ow.y); v0[3] += bf_hi(ow.y);
                        v1[0] += bf_lo(ow.z); v1[1] += bf_hi(ow.z); v1[2] += bf_lo(ow.w); v1[3] += bf_hi(ow.w); }
                    *(u32x4*)p = pack8(v0, v1); } }
    }
};
struct EpiRes {
    int final_;
    __device__ __forceinline__ void operator()(const f32x4 (&acc)[2][2][4][2], const Unit& u, int, int, int, int) const {
        EPI_LANE();
        const kargs_t ka = kargs(); unsigned char* ws = ka->ws; bf16_t* hb = (bf16_t*)(ws + WS_HB); bf16_t* lo = (bf16_t*)(ws + WS_LO); float* part = (float*)(ws + WS_PART); float* out = ka->out;
        const int row0 = u.pm * BM + wr * 64 + fr, col0 = u.pn * BM + wc * 32 + 8 * fq;
#pragma unroll
        for (int ai = 0; ai < 2; ++ai)
#pragma unroll
            for (int m = 0; m < 4; ++m) { const size_t row = (size_t)(row0 + ai * HALF + m * 16); float ss = 0.f;
#pragma unroll
                for (int bj = 0; bj < 2; ++bj) { const size_t off = row * DM + col0 + bj * HALF;
                    const u32x4 hw = *(const u32x4*)(hb + off), lw = *(const u32x4*)(lo + off);
                    f32x4 v0 = acc[ai][bj][m][0], v1 = acc[ai][bj][m][1];
                    v0[0] += bf_lo(hw.x) + bf_lo(lw.x); v0[1] += bf_hi(hw.x) + bf_hi(lw.x); v0[2] += bf_lo(hw.y) + bf_lo(lw.y); v0[3] += bf_hi(hw.y) + bf_hi(lw.y);
                    v1[0] += bf_lo(hw.z) + bf_lo(lw.z); v1[1] += bf_hi(hw.z) + bf_hi(lw.z); v1[2] += bf_lo(hw.w) + bf_lo(lw.w); v1[3] += bf_hi(hw.w) + bf_hi(lw.w);
                    if (final_) { *(f32x4*)(out + off) = v0; *(f32x4*)(out + off + 4) = v1; }
                    else {
                        const f32x4 q0 = v0 * v0, q1 = v1 * v1; ss += ((q0[0] + q0[1]) + (q0[2] + q0[3])) + ((q1[0] + q1[1]) + (q1[2] + q1[3]));
                        const u32x4 nh = pack8(v0, v1);
                        f32x4 r0, r1; r0[0] = v0[0] - bf_lo(nh.x); r0[1] = v0[1] - bf_hi(nh.x); r0[2] = v0[2] - bf_lo(nh.y); r0[3] = v0[3] - bf_hi(nh.y);
                        r1[0] = v1[0] - bf_lo(nh.z); r1[1] = v1[1] - bf_hi(nh.z); r1[2] = v1[2] - bf_lo(nh.w); r1[3] = v1[3] - bf_hi(nh.w);
                        *(u32x4*)(hb + off) = nh; *(u32x4*)(lo + off) = pack8(r0, r1); } }
                if (!final_) { ss += __shfl_xor(ss, 16); ss += __shfl_xor(ss, 32); if (fq == 0) part[row * 16 + u.pn * 4 + wc] = ss; } }
    }
};
struct EpiSwiglu {
    int dummy;
    __device__ __forceinline__ void operator()(const f32x4 (&acc)[2][2][4][2], const Unit& u, int, int, int, int) const {
        EPI_LANE();
        const kargs_t ka = kargs(); unsigned char* ws = ka->ws; bf16_t* H = (bf16_t*)(ws + WS_GATES); const float* part = (const float*)(ws + WS_PART);
        const int row0 = u.pm * BM + wr * 64 + fr, col0 = u.pn * HALF + wc * 32 + 8 * fq;
#pragma unroll
        for (int ai = 0; ai < 2; ++ai)
#pragma unroll
            for (int m = 0; m < 4; ++m) { const int row = row0 + ai * HALF + m * 16; const float r = row_rstd(part, row);
                f32x4 o[2];
#pragma unroll
                for (int n = 0; n < 2; ++n) { const f32x4 gv = acc[ai][0][m][n] * r, uv = acc[ai][1][m][n] * r;
#pragma unroll
                    for (int e = 0; e < 4; ++e) o[n][e] = gv[e] * fast_sigmoid(gv[e]) * uv[e]; }
                *(u32x4*)(H + (size_t)row * FF + col0) = pack8(o[0], o[1]); }
    }
};
}

namespace mix {
constexpr int SLOTB = 8192, L_K = 0, L_V = 2 * SLOTB, L_WS = 4 * SLOTB, L_OST = L_WS + NWAVES * 256, L_CS = L_OST + NWAVES * 4096, L_END = L_CS + SEQ * 4;
static_assert(L_END <= RING_BYTES, "mixer LDS");
typedef LAS const unsigned char* lds_cptr;
__device__ __forceinline__ int crow(int r, int hi) { return (r & 3) + 8 * (r >> 2) + 4 * hi; }
__device__ __forceinline__ void glds16(const void* gsrc, unsigned lds_dst) { unsigned keep;
    asm volatile("s_mov_b32 %0, m0\n\ts_mov_b32 m0, %2\n\ts_nop 0\n\tglobal_load_lds_dwordx4 %1, off\n\ts_mov_b32 m0, %0" : "=&s"(keep) : "v"(gsrc), "s"(lds_dst) : "memory"); }
typedef short v4i16_t __attribute__((ext_vector_type(4)));
__device__ __forceinline__ s16x4 vtr(lds_cptr p) { return __builtin_bit_cast(s16x4, __builtin_amdgcn_ds_read_tr16_b64_v4i16((LAS v4i16_t*)p)); }
#define MFMA32(a, b, c) __builtin_amdgcn_mfma_f32_32x32x16_bf16(a, b, c, 0, 0, 0)
__device__ __forceinline__ void qkt(f32x16& p0, f32x16& p1, lds_cptr kp, const bf16x8* qr, const f32x16& cinit) {
#pragma unroll
    for (int d0 = 0; d0 < 4; ++d0) {
        const bf16x8 b0 = *(const LAS bf16x8*)(kp + d0 * 2048), b1 = *(const LAS bf16x8*)(kp + d0 * 2048 + 512);
        if (d0 == 0) { p0 = MFMA32(b0, qr[0], cinit); p1 = MFMA32(b1, qr[0], cinit); }
        else { p0 = MFMA32(b0, qr[d0], p0); p1 = MFMA32(b1, qr[d0], p1); } }
}
__device__ __forceinline__ void pv(f32x16* o, lds_cptr vp, const u32x4& w0, const u32x4& w1, const u32x4& w2, const u32x4& w3) {
#pragma unroll
    for (int d0 = 0; d0 < 2; ++d0) {
        s16x4 lo[4], hi[4];
#pragma unroll
        for (int ks = 0; ks < 4; ++ks) { lo[ks] = vtr(vp + d0 * 4096 + ks * 1024); hi[ks] = vtr(vp + d0 * 4096 + ks * 1024 + 512); }
#define VPK(k) (bf16x8){lo[k][0], lo[k][1], lo[k][2], lo[k][3], hi[k][0], hi[k][1], hi[k][2], hi[k][3]}
        o[d0] = MFMA32(__builtin_bit_cast(bf16x8, w0), VPK(0), o[d0]);
        o[d0] = MFMA32(__builtin_bit_cast(bf16x8, w1), VPK(1), o[d0]);
        o[d0] = MFMA32(__builtin_bit_cast(bf16x8, w2), VPK(2), o[d0]);
        o[d0] = MFMA32(__builtin_bit_cast(bf16x8, w3), VPK(3), o[d0]);
#undef VPK
    }
}
__device__ __forceinline__ void pack_p(const f32x16& p0, const f32x16& p1, u32x4& w0, u32x4& w1, u32x4& w2, u32x4& w3) {
    w0 = (u32x4){cvt_pk_bf16(p0[0], p0[1]), cvt_pk_bf16(p0[2], p0[3]), cvt_pk_bf16(p0[4], p0[5]), cvt_pk_bf16(p0[6], p0[7])};
    w1 = (u32x4){cvt_pk_bf16(p0[8], p0[9]), cvt_pk_bf16(p0[10], p0[11]), cvt_pk_bf16(p0[12], p0[13]), cvt_pk_bf16(p0[14], p0[15])};
    w2 = (u32x4){cvt_pk_bf16(p1[0], p1[1]), cvt_pk_bf16(p1[2], p1[3]), cvt_pk_bf16(p1[4], p1[5]), cvt_pk_bf16(p1[6], p1[7])};
    w3 = (u32x4){cvt_pk_bf16(p1[8], p1[9]), cvt_pk_bf16(p1[10], p1[11]), cvt_pk_bf16(p1[12], p1[13]), cvt_pk_bf16(p1[14], p1[15])};
}
__device__ __forceinline__ float half_sum(float x) { auto rr = __builtin_amdgcn_permlane32_swap(__float_as_uint(x), __float_as_uint(x), false, false); return __uint_as_float(rr[0]) + __uint_as_float(rr[1]); }
__device__ __forceinline__ float half_max(float x) { auto rr = __builtin_amdgcn_permlane32_swap(__float_as_uint(x), __float_as_uint(x), false, false); return fmaxf(__uint_as_float(rr[0]), __uint_as_float(rr[1])); }

template <int KIND>
__device__ __forceinline__ void attn_unit(LAS unsigned char* shm, int b, int h, int qb) {
    const int tid = opaque_tid(), lane = tid & 63, r32 = lane & 31, hi = lane >> 5; const int wid = __builtin_amdgcn_readfirstlane(tid >> 6);
    const kargs_t ka = kargs(); bf16_t* mainA = (bf16_t*)ka->out; bf16_t* mainB = (bf16_t*)(ka->ws + WS_MB); const float* lgf = (const float*)(ka->ws + WS_LOGF);
    const bf16_t* Q = mainA + (KIND ? A_YD : A_YC); constexpr int ldq = PA;
    const bf16_t* K = KIND ? mainB + B_FK : mainA + A_SK; constexpr int ldk = KIND ? PB : PA;
    const bf16_t* V = mainB + (KIND ? B_FV : B_SV); constexpr int ldv = PB;
    bf16_t* O = mainA + (KIND ? A_YD : A_YC); constexpr int ldo = PA;
    const long rowbase = (long)b * SEQ; const int q0 = qb * 256;
    const unsigned ldsb = (unsigned)(uintptr_t)shm;
    LAS float* wsf = (LAS float*)(shm + L_WS) + wid * 64;
    LAS float* cs = (LAS float*)(shm + L_CS);
    if (KIND == 1) {
        float v[4];
#pragma unroll
        for (int i = 0; i < 4; ++i) v[i] = lgf[(size_t)(rowbase + 4 * tid + i) * 4 + h] * LOG2E;
        v[1] += v[0]; v[2] += v[1]; v[3] += v[2];
        const float tot = v[3]; float sc = tot;
#pragma unroll
        for (int o = 1; o < 64; o <<= 1) { const float y = __shfl_up(sc, o); if (lane >= o) sc += y; }
        if (lane == 63) wsf[0] = sc;
        LDS_WAIT(); __builtin_amdgcn_s_barrier(); asm volatile("" ::: "memory");
        float base = 0.f;
        for (int w = 0; w < wid; ++w) base += ((LAS float*)(shm + L_WS))[w * 64];
        const float ex = base + sc - tot;
        *(LAS f32x4*)(cs + 4 * tid) = (f32x4){ex + v[0], ex + v[1], ex + v[2], ex + v[3]};
        LDS_WAIT(); __builtin_amdgcn_s_barrier(); asm volatile("" ::: "memory");
    }
    const bf16_t* Qw = Q + (rowbase + q0 + wid * 32) * ldq + h * 64;
    const bf16_t* ksrc = K + rowbase * ldk + h * 64 + (long)lane * ldk + wid * 8;
    const bf16_t* vsrc = V + rowbase * ldv + h * 64 + (long)(16 * (wid & 3) + (lane >> 2)) * ldv + (wid >> 2) * 32 + (lane & 3) * 8;
    const unsigned kdst = ldsb + L_K + wid * 1024, vdst = ldsb + L_V + wid * 1024;
#define DMA_KV(t, slot) do { glds16(ksrc + (long)(t) * 64 * ldk, (unsigned)__builtin_amdgcn_readfirstlane(kdst + (slot))); glds16(vsrc + (long)(t) * 64 * ldv, (unsigned)__builtin_amdgcn_readfirstlane(vdst + (slot))); } while (0)
    const lds_cptr kp0 = (lds_cptr)shm + L_K + hi * 1024 + r32 * 16;
    const lds_cptr vp0 = (lds_cptr)shm + L_V + ((lane >> 4) & 1) * 32 + (lane & 3) * 8 + (4 * hi + ((lane & 15) >> 2)) * 64;
    const int NT = 4 * (qb + 1), tmaxw = 4 * qb + (wid >> 1);
    DMA_KV(NT - 1, 0);
    bf16x8 qr[4];
#pragma unroll
    for (int d0 = 0; d0 < 4; ++d0) qr[d0] = *(const bf16x8*)(Qw + (long)r32 * ldq + d0 * 16 + hi * 8);
    f32x16 o[2]; o[0] = f32x16{}; o[1] = f32x16{};
    const int rrel = 32 * (wid & 1) + r32;
    float mref = 0.f, lsum = 0.f, carry = 0.f;
    float crow2 = 0.f; if (KIND == 1) crow2 = cs[q0 + wid * 32 + r32];
    for (int i = 0; i < NT; ++i) {
        const int t = NT - 1 - i, slot = (i & 1) * SLOTB;
        if (i + 1 < NT) { DMA_KV(t - 1, SLOTB - slot); asm volatile("s_waitcnt vmcnt(2)" ::: "memory"); } else { asm volatile("s_waitcnt vmcnt(0)" ::: "memory"); }
        __builtin_amdgcn_s_barrier(); asm volatile("" ::: "memory");
        if (t <= tmaxw) {
            const bool diag = (t == tmaxw);
            f32x16 p0, p1; u32x4 w0, w1, w2, w3;
            if (KIND == 1) {
                f32x16 cinit;
#pragma unroll
                for (int r = 0; r < 16; ++r) cinit[r] = crow2 - mref;
                qkt(p0, p1, kp0 + slot, qr, cinit);
                LAS const float* csb = cs + 64 * t + 4 * hi;
#pragma unroll
                for (int g = 0; g < 4; ++g) { const f32x4 c0 = *(LAS const f32x4*)(csb + 8 * g), c1 = *(LAS const f32x4*)(csb + 32 + 8 * g);
#pragma unroll
                    for (int e = 0; e < 4; ++e) { p0[4 * g + e] -= c0[e]; p1[4 * g + e] -= c1[e]; } }
                if (diag) {
#pragma unroll
                    for (int r = 0; r < 16; ++r) { const int kr = crow(r, hi); if (kr > rrel) p0[r] = -INFINITY; if (kr + 32 > rrel) p1[r] = -INFINITY; } }
                float rm = fmaxf(p0[0], p1[0]);
#pragma unroll
                for (int r = 1; r < 16; ++r) rm = fmaxf(rm, fmaxf(p0[r], p1[r]));
                rm = half_max(rm);
                if (diag || __any(rm > 8.f)) {
                    const float dl = diag ? rm : fmaxf(rm, 0.f); mref += dl;
#pragma unroll
                    for (int r = 0; r < 16; ++r) { p0[r] -= dl; p1[r] -= dl; }
                    if (!diag) { const float f = __builtin_amdgcn_exp2f(-dl); lsum *= f; if (hi == 0) wsf[r32] = f; LDS_WAIT();
#pragma unroll
                        for (int r = 0; r < 16; ++r) { const float fr_ = wsf[crow(r, hi)]; o[0][r] *= fr_; o[1][r] *= fr_; }
                        LDS_WAIT(); } }
                float sacc = 0.f;
#pragma unroll
                for (int r = 0; r < 16; ++r) { p0[r] = __builtin_amdgcn_exp2f(p0[r]); p1[r] = __builtin_amdgcn_exp2f(p1[r]); sacc += p0[r] + p1[r]; }
                lsum += sacc;
            } else {
                f32x16 z16 = f32x16{};
                qkt(p0, p1, kp0 + slot, qr, z16);
                f32x16 l0, l1;
#pragma unroll
                for (int r = 0; r < 16; ++r) {
                    { const float y = p0[r], sp = fmaxf(y, 0.f) + __builtin_amdgcn_logf(1.f + __builtin_amdgcn_exp2f(-fabsf(y))); l0[r] = -sp; p0[r] = y - sp; }
                    { const float y = p1[r], sp = fmaxf(y, 0.f) + __builtin_amdgcn_logf(1.f + __builtin_amdgcn_exp2f(-fabsf(y))); l1[r] = -sp; p1[r] = y - sp; } }
                if (diag) {
#pragma unroll
                    for (int r = 0; r < 16; ++r) { const int kr = crow(r, hi); if (kr >= rrel) { l0[r] = 0.f; p0[r] = -INFINITY; } if (kr + 32 >= rrel) { l1[r] = 0.f; p1[r] = -INFINITY; } } }
                float run = carry;
#pragma unroll
                for (int blk = 1; blk >= 0; --blk)
#pragma unroll
                    for (int g = 3; g >= 0; --g) {
                        f32x16& L = blk ? l1 : l0; f32x16& P = blk ? p1 : p0;
                        const float a0 = L[4 * g], a1 = L[4 * g + 1], a2 = L[4 * g + 2], a3 = L[4 * g + 3];
                        const float gs = (a0 + a1) + (a2 + a3), T = half_sum(gs);
                        const float base = run + (hi ? 0.f : (T - gs));
                        run += T;
                        const float t3 = base, t2 = t3 + a3, t1 = t2 + a2, t0 = t1 + a1;
                        P[4 * g + 3] = __builtin_amdgcn_exp2f(P[4 * g + 3] + t3); P[4 * g + 2] = __builtin_amdgcn_exp2f(P[4 * g + 2] + t2);
                        P[4 * g + 1] = __builtin_amdgcn_exp2f(P[4 * g + 1] + t1); P[4 * g] = __builtin_amdgcn_exp2f(P[4 * g] + t0);
                    }
                carry = run;
            }
            pack_p(p0, p1, w0, w1, w2, w3);
            pv(o, vp0 + slot, w0, w1, w2, w3);
        }
        LDS_WAIT(); __builtin_amdgcn_s_barrier(); asm volatile("" ::: "memory");
    }
#undef DMA_KV
    float rli[16];
    if (KIND == 1) {
        lsum = half_sum(lsum);
        if (hi == 0) wsf[32 + r32] = lsum; LDS_WAIT();
#pragma unroll
        for (int r = 0; r < 16; ++r) rli[r] = __builtin_amdgcn_rcpf(wsf[32 + crow(r, hi)]);
    } else {
#pragma unroll
        for (int r = 0; r < 16; ++r) rli[r] = 1.f;
    }
    bf16_t* Ow = O + (rowbase + q0 + wid * 32) * ldo + h * 64;
    { LAS bf16_t* stg = (LAS bf16_t*)(shm + L_OST) + wid * 2048;
#pragma unroll
      for (int r = 0; r < 16; ++r) { const int orow = crow(r, hi);
#pragma unroll
          for (int d0 = 0; d0 < 2; ++d0) stg[orow * 64 + d0 * 32 + r32] = (bf16_t)(cvt_pk_bf16(o[d0][r] * rli[r], 0.f) & 0xffffu); }
      LDS_WAIT();
#pragma unroll
      for (int i = 0; i < 4; ++i) { const int row = i * 8 + (lane >> 3), ch = lane & 7; const u32x4 v = *(LAS const u32x4*)(stg + row * 64 + ch * 8); *(u32x4*)(Ow + (long)row * ldo + ch * 8) = v; } }
    LDS_WAIT(); __builtin_amdgcn_s_barrier(); asm volatile("" ::: "memory");
}

__device__ __forceinline__ void gmlp_unit(LAS unsigned char* shm, int b, int chunk, int l) {
    const int tid = opaque_tid(), lane = tid & 63, r32 = lane & 31, hi = lane >> 5; const int wid = __builtin_amdgcn_readfirstlane(tid >> 6);
    const kargs_t ka = kargs(); bf16_t* mainA = (bf16_t*)ka->out;
    const float* wsp = ka->in[4] + (size_t)l * 4 * 128 * 128; const float* bsp = ka->in[5] + (size_t)l * 4 * 128; const float* lng = ka->in[6] + (size_t)l * 256; const float* lnb = ka->in[7] + (size_t)l * 256;
    const long row0 = (long)b * SEQ + chunk * 128;
    { const int s = 16 * wid + (lane >> 2), g = lane & 3;
      const bf16_t* src = mainA + (row0 + s) * PA + A_V + g * 64;
      u32x4 w[8]; float x[64]; float sum = 0.f;
#pragma unroll
      for (int c = 0; c < 8; ++c) { w[c] = *(const u32x4*)(src + c * 8);
          x[8 * c] = bf_lo(w[c].x); x[8 * c + 1] = bf_hi(w[c].x); x[8 * c + 2] = bf_lo(w[c].y); x[8 * c + 3] = bf_hi(w[c].y);
          x[8 * c + 4] = bf_lo(w[c].z); x[8 * c + 5] = bf_hi(w[c].z); x[8 * c + 6] = bf_lo(w[c].w); x[8 * c + 7] = bf_hi(w[c].w); }
#pragma unroll
      for (int j = 0; j < 64; ++j) sum += x[j];
      sum += __shfl_xor(sum, 1); sum += __shfl_xor(sum, 2);
      const float mu = sum * (1.f / 256.f); float var = 0.f;
#pragma unroll
      for (int j = 0; j < 64; ++j) { x[j] -= mu; var += x[j] * x[j]; }
      var += __shfl_xor(var, 1); var += __shfl_xor(var, 2);
      const float rstd = rsqrtf(var * (1.f / 256.f) + EPS);
      const int st = s >> 6, sr = s & 63;
      LAS unsigned char* dstb = shm + (g * 2 + st) * 8192 + (sr >> 4) * 1024 + (sr & 15) * 64;
#pragma unroll
      for (int c = 0; c < 8; ++c) { f32x4 a, bq;
#pragma unroll
          for (int e = 0; e < 4; ++e) { const int ch = g * 64 + 8 * c + e; a[e] = x[8 * c + e] * rstd * lng[ch] + lnb[ch]; bq[e] = x[8 * c + 4 + e] * rstd * lng[ch + 4] + lnb[ch + 4]; }
          *(LAS u32x4*)(dstb + (c >> 2) * 4096 + (c & 3) * 16) = pg8::pack8(a, bq); }
    }
    LDS_WAIT(); __builtin_amdgcn_s_barrier(); asm volatile("" ::: "memory");
#pragma unroll 1
    for (int jj = 0; jj < 2; ++jj) {
        const int job = wid + 8 * jj, g = job & 3, tb = job >> 2, t = 32 * tb + r32;
        f32x16 o[2]; o[0] = f32x16{}; o[1] = f32x16{};
        const float* wrow = wsp + ((size_t)g * 128 + t) * 128;
        for (int st = 0; st <= (tb >> 1); ++st) {
            u32x4 w4[4];
#pragma unroll
            for (int ks = 0; ks < 4; ++ks) { f32x4 a[2];
#pragma unroll
                for (int j2 = 0; j2 < 2; ++j2) { const int s0 = 64 * st + 16 * ks + 8 * j2 + 4 * hi; a[j2] = *(const f32x4*)(wrow + s0);
#pragma unroll
                    for (int e = 0; e < 4; ++e) if (s0 + e > t) a[j2][e] = 0.f; }
                w4[ks] = pg8::pack8(a[0], a[1]); }
            const lds_cptr vp = (lds_cptr)shm + (g * 2 + st) * 8192 + ((lane >> 4) & 1) * 32 + (lane & 3) * 8 + (4 * hi + ((lane & 15) >> 2)) * 64;
            pv(o, vp, w4[0], w4[1], w4[2], w4[3]);
        }
#pragma unroll
        for (int r = 0; r < 16; ++r) { const int tt = 32 * tb + crow(r, hi); const float bb = bsp[g * 128 + tt];
#pragma unroll
            for (int d0 = 0; d0 < 2; ++d0) { bf16_t* p = mainA + (row0 + tt) * PA + A_YB + g * 64 + d0 * 32 + r32;
                const float uu = __uint_as_float((unsigned)(*p) << 16);
                *p = (bf16_t)(cvt_pk_bf16(uu * (o[d0][r] + bb), 0.f) & 0xffffu); } }
    }
    LDS_WAIT(); __builtin_amdgcn_s_barrier(); asm volatile("" ::: "memory");
}
__device__ __forceinline__ void conv_unit(int unit, int l) {
    const int tid = opaque_tid(), cg = tid & 31, rg = tid >> 5;
    const kargs_t ka = kargs(); bf16_t* mainA = (bf16_t*)ka->out; const float* wconv = ka->in[3] + (size_t)l * 3 * 256;
    const int c0 = cg * 8;
    float w[3][8];
#pragma unroll
    for (int k = 0; k < 3; ++k) { const f32x4 a = *(const f32x4*)(wconv + k * 256 + c0), bq = *(const f32x4*)(wconv + k * 256 + c0 + 4);
#pragma unroll
        for (int e = 0; e < 4; ++e) { w[k][e] = a[e]; w[k][4 + e] = bq[e]; } }
    const long rbase = (long)unit * 64 + rg * 4;
    float xc[6][8];
#pragma unroll
    for (int i = 0; i < 6; ++i) { const long row = rbase - 2 + i; const bool ok = (i >= 2) || ((int)(rbase & (SEQ - 1)) + i - 2 >= 0);
        if (ok) { const u32x4 a = *(const u32x4*)(mainA + row * PA + A_CC + c0), bq = *(const u32x4*)(mainA + row * PA + A_CX + c0);
            xc[i][0] = bf_lo(a.x) * bf_lo(bq.x); xc[i][1] = bf_hi(a.x) * bf_hi(bq.x); xc[i][2] = bf_lo(a.y) * bf_lo(bq.y); xc[i][3] = bf_hi(a.y) * bf_hi(bq.y);
            xc[i][4] = bf_lo(a.z) * bf_lo(bq.z); xc[i][5] = bf_hi(a.z) * bf_hi(bq.z); xc[i][6] = bf_lo(a.w) * bf_lo(bq.w); xc[i][7] = bf_hi(a.w) * bf_hi(bq.w); }
        else {
#pragma unroll
            for (int e = 0; e < 8; ++e) xc[i][e] = 0.f; } }
#pragma unroll
    for (int i = 0; i < 4; ++i) { const long row = rbase + i; bf16_t* p = mainA + row * PA + A_YA + c0; const u32x4 cbw = *(const u32x4*)p;
        float cbv[8] = {bf_lo(cbw.x), bf_hi(cbw.x), bf_lo(cbw.y), bf_hi(cbw.y), bf_lo(cbw.z), bf_hi(cbw.z), bf_lo(cbw.w), bf_hi(cbw.w)}; f32x4 o0, o1;
#pragma unroll
        for (int e = 0; e < 4; ++e) { o0[e] = cbv[e] * (w[0][e] * xc[i][e] + w[1][e] * xc[i + 1][e] + w[2][e] * xc[i + 2][e]);
            o1[e] = cbv[4 + e] * (w[0][4 + e] * xc[i][4 + e] + w[1][4 + e] * xc[i + 1][4 + e] + w[2][4 + e] * xc[i + 2][4 + e]); }
        *(u32x4*)p = pg8::pack8(o0, o1); }
}
}

#define XB_TMO      128
#define XB_XCNT(j)  (256  + 64 * (j))
#define XB_XSUB(j)  (1280 + 64 * (j))
#define XB_XGEN(j)  (2304 + 64 * (j))
#define XB_TOP      3328
#define XB_TOPGEN   3392
#define XCD_BAR_WORDS 3456
#define XB_SPIN_CAP (1u << 18)
__device__ __forceinline__ unsigned xb_ld(unsigned* p)              { return __hip_atomic_load(p, __ATOMIC_RELAXED, __HIP_MEMORY_SCOPE_AGENT); }
__device__ __forceinline__ unsigned xb_add(unsigned* p, unsigned v) { return __hip_atomic_fetch_add(p, v, __ATOMIC_RELAXED, __HIP_MEMORY_SCOPE_AGENT); }
__device__ __forceinline__ unsigned xb_xcc_id() { return (unsigned)__builtin_amdgcn_s_getreg((3 << 11) | 20) & 0xFu; }
#define XB_SPIN(cond, bar) do { unsigned _sp = 0; while (cond) { __builtin_amdgcn_s_sleep(1); \
    if ((++_sp & 255u) == 0u) { if (xb_ld(&(bar)[XB_TMO])) break; if (_sp > XB_SPIN_CAP) { atomicAdd(&(bar)[XB_TMO], 1u); break; } } } } while (0)
struct XcdBarrier { unsigned* bar; unsigned x; volatile LAS unsigned* st; };
__device__ __forceinline__ XcdBarrier xcd_barrier_post(unsigned* bar, volatile LAS unsigned* st) {
    XcdBarrier b; b.bar = bar; b.x = xb_xcc_id(); b.st = st;
    if (threadIdx.x == 0) (void)xb_add(&bar[XB_XCNT(b.x)], 1u);
    return b;
}
__device__ __forceinline__ void xcd_barrier_complete(unsigned* bar, unsigned x, unsigned& nloc, unsigned& nx) {
    const unsigned G = gridDim.x * gridDim.y * gridDim.z;
    unsigned sum, cnt, mine, sp = 0u;
    for (;;) {
        sum = 0u; cnt = 0u; mine = 0u;
#pragma unroll
        for (unsigned j = 0; j < 16; ++j) { const unsigned c = xb_ld(&bar[XB_XCNT(j)]); sum += c; cnt += (c > 0u) ? 1u : 0u; mine = (j == x) ? c : mine; }
        if (sum == G) break;
        __builtin_amdgcn_s_sleep(1);
        if ((++sp & 255u) == 0u) { if (xb_ld(&bar[XB_TMO])) break; if (sp > XB_SPIN_CAP) { atomicAdd(&bar[XB_TMO], 1u); break; } }
    }
    nloc = mine > 0u ? mine : 1u; nx = cnt > 0u ? cnt : 1u;
}
__device__ __forceinline__ void xcd_barrier(const XcdBarrier& b) {
    asm volatile("s_waitcnt vmcnt(0)" ::: "memory");
    __syncthreads();
    if (threadIdx.x == 0) {
        unsigned* bar = b.bar;
        __builtin_amdgcn_s_waitcnt(0);
        unsigned nloc = b.st[0], nx = b.st[1];
        if (nloc == 0u) { xcd_barrier_complete(bar, b.x, nloc, nx); b.st[0] = nloc; b.st[1] = nx; }
        const unsigned old = xb_add(&bar[XB_XSUB(b.x)], 1u);
        const unsigned gen = old / nloc;
        if (old + 1u == (gen + 1u) * nloc) {
            __builtin_amdgcn_fence(__ATOMIC_RELEASE, "agent");
            asm volatile("s_waitcnt vmcnt(0)" ::: "memory");
            const unsigned og = xb_add(&bar[XB_TOP], 1u);
            const unsigned tg = og / nx;
            if (og + 1u == (tg + 1u) * nx) xb_add(&bar[XB_TOPGEN], 1u);
            else XB_SPIN(xb_ld(&bar[XB_TOPGEN]) == tg, bar);
            __builtin_amdgcn_fence(__ATOMIC_ACQUIRE, "agent");
            xb_add(&bar[XB_XGEN(b.x)], 1u);
            asm volatile("s_waitcnt vmcnt(0)" ::: "memory");
        } else {
            XB_SPIN(xb_ld(&bar[XB_XGEN(b.x)]) == gen, bar);
            __builtin_amdgcn_fence(__ATOMIC_ACQUIRE, "agent");
            asm volatile("s_waitcnt vmcnt(0)" ::: "memory");
        }
    }
    __syncthreads();
}

__device__ __forceinline__ float wave_sum(float v) {
#pragma unroll
    for (int o = 1; o < 64; o <<= 1) v += __shfl_xor(v, o);
    return v;
}
__device__ __forceinline__ void tr_item(const float* W, int ldw, const float* ks, bf16_t* WT, int K, int k0, int p0, int src0, int nvalid, LAS float* scr, int lane) {
#pragma unroll 8
    for (int i = 0; i < 32; ++i) { const int kk = 2 * i + (lane >> 5), n = lane & 31;
        float v = 0.f; if (n < nvalid) { v = W[(size_t)(k0 + kk) * ldw + src0 + n]; if (ks) v *= ks[k0 + kk]; }
        scr[kk * 33 + n] = v; }
    LDS_WAIT(); asm volatile("" ::: "memory");
    const int c = lane & 7;
#pragma unroll
    for (int j = 0; j < 4; ++j) { const int n = (lane >> 3) + 8 * j; const LAS float* s = scr + (8 * c) * 33 + n;
        u32x4 o; o.x = cvt_pk_bf16(s[0 * 33], s[1 * 33]); o.y = cvt_pk_bf16(s[2 * 33], s[3 * 33]); o.z = cvt_pk_bf16(s[4 * 33], s[5 * 33]); o.w = cvt_pk_bf16(s[6 * 33], s[7 * 33]);
        *(u32x4*)(WT + (size_t)(p0 + n) * K + k0 + 8 * c) = o; }
    LDS_WAIT(); asm volatile("" ::: "memory");
}

constexpr int PH_PER_LAYER = 7, N_PHASES = DEPTH * PH_PER_LAYER;

__global__ void __launch_bounds__(NWAVES * 64, 2) mk_fwd(Args args) {
    extern __shared__ __attribute__((aligned(16))) unsigned char lds_raw[];
    LAS unsigned char* lds = (LAS unsigned char*)lds_raw;
    volatile LAS unsigned* MISC = (volatile LAS unsigned*)(lds + MISC_OFF);
    const int G = gridDim.x, bx = blockIdx.x;
    { const int tid = threadIdx.x; for (int u = tid; u < (LDS_BYTES - LDSCTL_OFF) / 4; u += NWAVES * 64) ((LAS unsigned*)(lds + LDSCTL_OFF))[u] = 0u; }
    __syncthreads();
    XcdBarrier bar = xcd_barrier_post((unsigned*)(args.ws + WS_CTL) + CW_BAR, MISC + 8);
    const int lo_ph = args.ph_lo, hi_ph = args.ph_hi;
#ifndef PHMASK
#define PHMASK 0x7f
#endif
#define IN(k) (((PHMASK >> ((k) % PH_PER_LAYER)) & 1) && lo_ph <= (k) && (k) < hi_ph)
#define SEAM(k) do { if (lo_ph <= (k) && (k) + 1 < hi_ph) xcd_barrier(bar); } while (0)

#pragma unroll 1
    for (int l = 0; l < DEPTH; ++l) {
        const int pb = l * PH_PER_LAYER;
        if (IN(pb + 0)) {
            const int tid = opaque_tid(), lane = tid & 63, wave = __builtin_amdgcn_readfirstlane(tid >> 6);
            const int vcu = (G % 8 == 0) ? (bx % 8) * (G / 8) + bx / 8 : bx;
            const kargs_t ka = kargs(); unsigned char* ws = ka->ws;
            LAS float* scr = (LAS float*)(lds + wave * 16384);
            const int gw = vcu * NWAVES + wave, NGW = G * NWAVES;
            constexpr int I_IN = 16 * (NP1 / 32), I_BR = 4 * 4 * 32, I_OUT = 16 * 32, I_F1 = 16 * (NF1 / 32), I_F2 = (FF / 64) * 32;
            constexpr int NITEMS = I_IN + I_BR + I_OUT + I_F1 + I_F2;
#pragma unroll 1
            for (int it = gw; it < NITEMS; it += NGW) {
                int r = it;
                if (r < I_IN) { const int kb = r / (NP1 / 32), nb = r % (NP1 / 32), pn = nb >> 3, q = nb & 7, chb = 64 * (q & 3) + 32 * (q >> 2);
                    int src0, nvalid = 32;
                    if (pn <= 10) src0 = 256 * pn + chb; else if (pn <= 26) src0 = 2820 + 256 * (pn - 11) + chb; else { src0 = 2816; nvalid = (q == 0) ? 4 : 0; }
                    tr_item(ka->in[2] + (size_t)l * DM * NIN, NIN, ka->in[1] + (size_t)l * DM, (bf16_t*)(ws + WS_WIN), DM, 64 * kb, 32 * nb, src0, nvalid, scr, lane); continue; }
                r -= I_IN;
                if (r < I_BR) { const int z = r / 128, rr = r % 128, kb = rr / 32, nb = rr % 32;
                    tr_item(ka->in[11] + ((size_t)l * 4 + z) * 256 * DM, DM, nullptr, (bf16_t*)(ws + WS_WBR) + (size_t)z * DM * 256, 256, 64 * kb, 32 * nb, 32 * nb, 32, scr, lane); continue; }
                r -= I_BR;
                if (r < I_OUT) { const int kb = r / 32, nb = r % 32; tr_item(ka->in[12] + (size_t)l * DM * DM, DM, nullptr, (bf16_t*)(ws + WS_WOUT), DM, 64 * kb, 32 * nb, 32 * nb, 32, scr, lane); continue; }
                r -= I_OUT;
                if (r < I_F1) { const int kb = r / (NF1 / 32), nb = r % (NF1 / 32), pn = nb >> 3, q = nb & 7;
                    tr_item(ka->in[14] + (size_t)l * DM * NF1, NF1, ka->in[13] + (size_t)l * DM, (bf16_t*)(ws + WS_WF1), DM, 64 * kb, 32 * nb, ((q >> 2) ? FF : 0) + 128 * pn + 32 * (q & 3), 32, scr, lane); continue; }
                r -= I_F1;
                { const int kb = r / 32, nb = r % 32; tr_item(ka->in[15] + (size_t)l * FF * DM, DM, nullptr, (bf16_t*)(ws + WS_WF2), FF, 64 * kb, 32 * nb, 32 * nb, 32, scr, lane); }
            }
            if (l == 0) {
                const float* x = ka->in[0]; bf16_t* HB = (bf16_t*)(ws + WS_HB); bf16_t* LO = (bf16_t*)(ws + WS_LO); float* part = (float*)(ws + WS_PART);
#pragma unroll 1
                for (int m = gw; m < M; m += NGW) {
                    const f32x4* xr = (const f32x4*)(x + (size_t)m * DM) + lane; f32x4 v[4]; float s = 0.f;
#pragma unroll
                    for (int j = 0; j < 4; ++j) { v[j] = xr[64 * j]; s += (v[j][0] * v[j][0] + v[j][1] * v[j][1]) + (v[j][2] * v[j][2] + v[j][3] * v[j][3]); }
                    s = wave_sum(s);
                    u32x2* hb8 = (u32x2*)(HB + (size_t)m * DM) + lane; u32x2* lo8 = (u32x2*)(LO + (size_t)m * DM) + lane;
#pragma unroll
                    for (int j = 0; j < 4; ++j) { u32x2 hw; hw.x = cvt_pk_bf16(v[j][0], v[j][1]); hw.y = cvt_pk_bf16(v[j][2], v[j][3]);
                        u32x2 lw; lw.x = cvt_pk_bf16(v[j][0] - bf_lo(hw.x), v[j][1] - bf_hi(hw.x)); lw.y = cvt_pk_bf16(v[j][2] - bf_lo(hw.y), v[j][3] - bf_hi(hw.y));
                        hb8[64 * j] = hw; lo8[64 * j] = lw; }
                    if (lane < 16) part[(size_t)m * 16 + lane] = (lane == 0) ? s : 0.f;
                }
            }
        }
        SEAM(pb + 0);
        if (IN(pb + 1)) {
            const kargs_t ka = kargs();
            pg8::Gemm g{(const bf16_t*)(ka->ws + WS_HB), (const bf16_t*)(ka->ws + WS_WIN), DM, DM, 0, 0}; pg8::StaticOrder S; S.init(M, NP1, G, bx);
            pg8::EpiP1 E{l};
            pg8::gemm_phase(lds, g, S, E);
        }
        SEAM(pb + 1);
        if (IN(pb + 2)) {
            constexpr int N_ATT = 512, N_GM = 128, N_CV = M / 64, N_ITEMS = N_ATT + N_GM + N_CV;
#pragma unroll 1
            for (;;) {
                if (threadIdx.x == 0) { const kargs_t ka = kargs(); MISC[16] = xb_add((unsigned*)(ka->ws + WS_CTL) + CW_QUEUE + 64 * l, 1u); }
                __syncthreads();
                int it = (int)MISC[16];
                __syncthreads();
                it = __builtin_amdgcn_readfirstlane(it);
                if (it >= N_ITEMS) break;
                if (it < N_ATT) { const int qb = 7 - (it >> 6), kind = (it >> 5) & 1, bh = it & 31, b = bh >> 2, h = bh & 3;
                    if (kind) mix::attn_unit<1>(lds, b, h, qb); else mix::attn_unit<0>(lds, b, h, qb);
                } else if (it < N_ATT + N_GM) { const int j = it - N_ATT; mix::gmlp_unit(lds, j >> 4, j & 15, l); }
                else mix::conv_unit(it - N_ATT - N_GM, l);
            }
        }
        SEAM(pb + 2);
        if (IN(pb + 3)) {
            const kargs_t ka = kargs();
            pg8::Gemm g{(const bf16_t*)ka->out, (const bf16_t*)(ka->ws + WS_WBR), PA, 256, 256, (size_t)DM * 256}; pg8::BranchOrder S; S.s.init(M, DM, G, bx);
            pg8::EpiBranch E{0};
            pg8::gemm_phase(lds, g, S, E);
        }
        SEAM(pb + 3);
        if (IN(pb + 4)) {
            const kargs_t ka = kargs();
            pg8::Gemm g{(const bf16_t*)ka->out + A_MRG, (const bf16_t*)(ka->ws + WS_WOUT), PA, DM, 0, 0}; pg8::StaticOrder S; S.init(M, DM, G, bx);
            pg8::EpiRes E{0};
            pg8::gemm_phase(lds, g, S, E);
        }
        SEAM(pb + 4);
        if (IN(pb + 5)) {
            const kargs_t ka = kargs();
            pg8::Gemm g{(const bf16_t*)(ka->ws + WS_HB), (const bf16_t*)(ka->ws + WS_WF1), DM, DM, 0, 0}; pg8::StaticOrder S; S.init(M, NF1, G, bx);
            pg8::EpiSwiglu E{0};
            pg8::gemm_phase(lds, g, S, E);
        }
        SEAM(pb + 5);
        if (IN(pb + 6)) {
            const kargs_t ka = kargs();
            pg8::Gemm g{(const bf16_t*)(ka->ws + WS_GATES), (const bf16_t*)(ka->ws + WS_WF2), FF, FF, 0, 0}; pg8::StaticOrder S; S.init(M, DM, G, bx);
            pg8::EpiRes E{(l == DEPTH - 1) ? 1 : 0};
            pg8::gemm_phase(lds, g, S, E);
        }
        if (l + 1 < DEPTH) SEAM(pb + 6);
    }
#undef IN
#undef SEAM
}

#ifndef MK_PER_PHASE
#define MK_PER_PHASE 0
#endif
extern "C" void kernel_launch(void* const* d_in, const int* in_sizes, int n_in, void* d_out, int out_size, void* d_ws, size_t ws_size, hipStream_t stream) {
    static int grid = 0;
    if (grid == 0) {
        if (n_in != 16 || out_size != M * DM || ws_size < WS_END) { fprintf(stderr, "kernel_launch: unexpected shapes (n_in %d out %d ws %zu)\n", n_in, out_size, ws_size); grid = -1; return; }
        int dev = 0, cus = 0, per_cu = 0;
        if (hipGetDevice(&dev) != hipSuccess || hipDeviceGetAttribute(&cus, hipDeviceAttributeMultiprocessorCount, dev) != hipSuccess) { grid = -1; return; }
        if (hipFuncSetAttribute((const void*)mk_fwd, hipFuncAttributeMaxDynamicSharedMemorySize, LDS_BYTES) != hipSuccess) { fprintf(stderr, "kernel_launch: hipFuncSetAttribute failed\n"); grid = -1; return; }
        if (hipOccupancyMaxActiveBlocksPerMultiprocessor(&per_cu, (const void*)mk_fwd, NWAVES * 64, LDS_BYTES) != hipSuccess || per_cu < 1) { fprintf(stderr, "kernel_launch: occupancy query says %d blocks per CU\n", per_cu); }
        (void)hipGetLastError();
        grid = cus;
        if (grid != 256) fprintf(stderr, "kernel_launch: %d CUs (built for 256)\n", grid);
    }
    if (grid < 0) return;
    (void)hipMemsetAsync((char*)d_ws + WS_CTL, 0, CTL_ZERO_BYTES, stream);
    Args a{};
    for (int i = 0; i < 16; ++i) a.in[i] = (const float*)d_in[i];
    a.out = (float*)d_out; a.ws = (unsigned char*)d_ws;
#if MK_PER_PHASE
    for (int p = 0; p < N_PHASES; ++p) { a.ph_lo = p; a.ph_hi = p + 1; hipLaunchKernelGGL(mk_fwd, dim3(grid), dim3(NWAVES * 64), LDS_BYTES, stream, a); }
#else
    a.ph_lo = 0; a.ph_hi = N_PHASES;
    void* kargs[] = {&a};
    hipError_t e = hipLaunchCooperativeKernel((const void*)mk_fwd, dim3(grid), dim3(NWAVES * 64), kargs, LDS_BYTES, stream);
    if (e != hipSuccess) fprintf(stderr, "kernel_launch: cooperative launch failed: %s\n", hipGetErrorString(e));
#endif
}
```

```cpp
#include <hip/hip_runtime.h>
#include <hip/hip_bf16.h>
#include <cstdio>
#include <cstdint>
#include <cstddef>

#define LAS __attribute__((address_space(3)))
#define GAS __attribute__((address_space(1)))
typedef unsigned short bf16_t;
typedef short bf16x8 __attribute__((ext_vector_type(8)));
typedef short s16x4 __attribute__((ext_vector_type(4)));
typedef float f32x4 __attribute__((ext_vector_type(4)));
typedef float f32x2 __attribute__((ext_vector_type(2)));
typedef float f32x16 __attribute__((ext_vector_type(16)));
typedef unsigned u32x4 __attribute__((ext_vector_type(4)));
typedef unsigned u32x2 __attribute__((ext_vector_type(2)));

constexpr int DM = 1024, NBATCH = 8, SEQ = 2048, M = NBATCH * SEQ, DEPTH = 2, NIN = 6916, FF = 2816;
constexpr int NP1 = 28 * 256;
constexpr int NF1 = 2 * FF;
constexpr int PA = 2048, PB = 768, PG = 4096;
constexpr int A_YA = 0  , A_YB = 256  , A_YC = 512  , A_YD = 768  , A_CC = 1024, A_CX = 1280, A_V = 1536, A_SK = 1792, A_MRG = 1024  ;
constexpr int B_SV = 0, B_FK = 256, B_FV = 512;
constexpr float LOG2E = 1.4426950408889634f;
constexpr float QSCALE = 0.125f * LOG2E;
constexpr float EPS = 1e-6f;

constexpr size_t MiB = 1u << 20;
constexpr size_t WS_CTL = 0, CTL_ZERO_BYTES = 1 * MiB;
constexpr size_t WS_WIN = 1 * MiB, WS_WBR = 15 * MiB, WS_WOUT = 17 * MiB, WS_WF1 = 19 * MiB, WS_WF2 = 30 * MiB;
constexpr size_t WS_PART = 36 * MiB, WS_LOGF = 37 * MiB, WS_HB = 38 * MiB, WS_LO = 70 * MiB, WS_MB = 102 * MiB, WS_GATES = 126 * MiB, WS_END = 254 * MiB;
static_assert(WS_WIN + (size_t)NP1 * DM * 2 <= WS_WBR && WS_WF1 + (size_t)NF1 * DM * 2 <= WS_WF2 && WS_WF2 + (size_t)DM * FF * 2 <= WS_PART, "weights map");
static_assert(WS_MB + (size_t)M * PB * 2 <= WS_GATES && WS_GATES + (size_t)M * PG * 2 <= WS_END && (size_t)M * FF * 2 <= (size_t)M * PG * 2, "activation map");
constexpr int CW_TMO = 0, CW_CODE = 1, CW_BAR = 4096, CW_QUEUE = 8192;

constexpr int RING_BYTES = 131072, LDSCTL_OFF = RING_BYTES, MISC_OFF = LDSCTL_OFF + 320, LDS_BYTES = 147456;
constexpr int NWAVES = 8;

__device__ __forceinline__ unsigned cvt_pk_bf16(float lo, float hi) { typedef __bf16 bf2 __attribute__((ext_vector_type(2))); f32x2 v = {lo, hi}; bf2 b = __builtin_convertvector(v, bf2); return __builtin_bit_cast(unsigned, b); }
__device__ __forceinline__ float bf_lo(unsigned w) { return __uint_as_float(w << 16); }
__device__ __forceinline__ float bf_hi(unsigned w) { return __uint_as_float(w & 0xffff0000u); }
__device__ __forceinline__ float fast_sigmoid(float x) { return __builtin_amdgcn_rcpf(1.f + __builtin_amdgcn_exp2f(-LOG2E * x)); }
__device__ __forceinline__ float gelu_tanh_f(float x) { const float t = x * (1.f + 0.044715f * x * x); return x * __builtin_amdgcn_rcpf(1.f + __builtin_amdgcn_exp2f(-2.302208198f * t)); }
__device__ __forceinline__ float logsig_f(float x) { return fminf(x, 0.f) - log1pf(expf(-fabsf(x))); }
#define LDS_WAIT() asm volatile("s_waitcnt lgkmcnt(0)" ::: "memory")
#define VM_WAIT() asm volatile("s_waitcnt vmcnt(0)" ::: "memory")
#define OPQ_V(x) asm volatile("" : "+v"(x))
#define OPQ_S(x) asm volatile("" : "+s"(x))
struct Args { const float* in[16]; float* out; unsigned char* ws; int ph_lo, ph_hi; };
typedef const __attribute__((address_space(4))) Args* kargs_t;
__device__ __forceinline__ kargs_t kargs() { kargs_t p = (kargs_t)__builtin_amdgcn_kernarg_segment_ptr(); OPQ_S(p); return p; }
__device__ __forceinline__ int opaque_tid() { int t = threadIdx.x; OPQ_V(t); return t; }

namespace pg8 {
constexpr int BM = 256, BK = 64, HALF = 128, HTB = HALF * BK * 2, STAGE_BYTES = 8 * HTB, NXCD = 8, WGM = 8;
__host__ __device__ __forceinline__ int lds_byte(int r, int c) { const int st = (r >> 4) * 2 + (c >> 5), rr = r & 15, cc = c & 31, ob = rr * 64 + cc * 2; return st * 1024 + (ob ^ (((ob >> 9) & 1) << 5)); }
__host__ __device__ __forceinline__ void stage_rc(int b, int& R, int& C) { const int st = b / 1024, sb = b % 1024, swz = sb ^ (((sb >> 9) & 1) << 5); R = (st >> 1) * 16 + swz / 64; C = (st & 1) * 32 + (swz % 64) / 2; }
__host__ __device__ __forceinline__ int perm32(int rho) { const int n = rho >> 4, i = rho & 15; return 8 * (i >> 2) + 4 * n + (i & 3); }

struct Unit { int pm, pn, z; };
struct Gemm { const bf16_t* A; const bf16_t* Bt; int lda, K; size_t azs, bzs; };

struct StaticOrder {
    int nM, nN, nwg, G, c;
    __host__ __device__ void init(int M_, int N_, int G_, int c_) { nM = M_ / BM; nN = N_ / BM; nwg = nM * nN; G = G_; c = c_; }
    __host__ __device__ bool next(int i, Unit& u) const {
        const long L = (long)i * G + c; if (L >= nwg) return false;
        int wgid = (int)L; { const int q = nwg / NXCD, r = nwg % NXCD, xcd = wgid % NXCD, off = wgid / NXCD; wgid = (xcd < r ? xcd * (q + 1) : r * (q + 1) + (xcd - r) * q) + off; }
        const int nig = WGM * nN, gid = wgid / nig, fm = gid * WGM, gsz = (nM - fm) < WGM ? (nM - fm) : WGM;
        u.pm = fm + ((wgid % nig) % gsz); u.pn = (wgid % nig) / gsz; u.z = 0; return true;
    }
};
struct BranchOrder {
    StaticOrder s;
    __host__ __device__ bool next(int i, Unit& u) const { if (i >= 4) return false; if (!s.next(0, u)) return false; u.z = i; return true; }
};

template <class Epi, class Sched>
__device__ __forceinline__ void gemm_phase(LAS unsigned char* lds, const Gemm g, const Sched& S, const Epi& E) {
    const int tid = opaque_tid(), wid = __builtin_amdgcn_readfirstlane(tid >> 6), lane = tid & 63, wr = wid >> 2, wc = wid & 3, fr = lane & 15, fq = lane >> 4;
    const int K = g.K, nt = K / BK;
    unsigned voffA[2], voffB[2];
#pragma unroll
    for (int i = 0; i < 2; ++i) { int R, C; stage_rc(tid * 16 + i * 8192, R, C); const int Rb = (R & ~31) + perm32(R & 31);
        voffA[i] = (unsigned)(R * g.lda + C) * 2u; voffB[i] = (unsigned)(Rb * K + C) * 2u; }
    const size_t kstep = (size_t)(BK * 2);
    const size_t hstepA = (size_t)HALF * g.lda * 2, tstepA = 2 * hstepA;
    const size_t hstepB = (size_t)HALF * K * 2, tstepB = 2 * hstepB;
    const unsigned ldsw = (unsigned)wid * 1024u;
    const int aoff = lds_byte(wr * 64 + fr, fq * 8), boff = lds_byte(wc * 32 + fr, fq * 8);
#define PG8_SA(b, h) (((b) * 2 + (h)) * HTB)
#define PG8_SB(b, h) ((4 + (b) * 2 + (h)) * HTB)
#define PG8_STAGE(bufoff, gbase, voff) do { _Pragma("unroll") for (int _i = 0; _i < 2; ++_i) \
        __builtin_amdgcn_global_load_lds((const unsigned*)((const char*)(gbase) + (voff)[_i]), (LAS unsigned*)(lds + (bufoff) + ldsw + _i * 8192), 16, 0, 0); } while (0)
#define PG8_LDA(dst, b, h) do { _Pragma("unroll") for (int m = 0; m < 4; ++m) _Pragma("unroll") for (int k = 0; k < 2; ++k) dst[m][k] = *(const LAS bf16x8*)(lds + PG8_SA(b, h) + aoff + m * 2048 + k * 1024); } while (0)
#define PG8_LDB(dst, b, h) do { _Pragma("unroll") for (int n = 0; n < 2; ++n) _Pragma("unroll") for (int k = 0; k < 2; ++k) dst[n][k] = *(const LAS bf16x8*)(lds + PG8_SB(b, h) + boff + n * 2048 + k * 1024); } while (0)
#define PG8_MMA(ai, bj, At, Bt) do { __builtin_amdgcn_s_setprio(1); _Pragma("unroll") for (int m = 0; m < 4; ++m) _Pragma("unroll") for (int n = 0; n < 2; ++n) _Pragma("unroll") for (int k = 0; k < 2; ++k) \
        acc[ai][bj][m][n] = __builtin_amdgcn_mfma_f32_16x16x32_bf16(Bt[n][k], At[m][k], acc[ai][bj][m][n], 0, 0, 0); __builtin_amdgcn_s_setprio(0); } while (0)
#define PG8_WAIT_V(n) asm volatile("s_waitcnt vmcnt(" #n ")" ::: "memory")
#define PG8_WAIT_L(n) asm volatile("s_waitcnt lgkmcnt(" #n ")" ::: "memory")
#define PG8_BAR __builtin_amdgcn_s_barrier()
#define PG8_SCHED __builtin_amdgcn_sched_barrier(0)
    Unit cur, nxt; int ui = 0;
    if (!S.next(0, cur)) return;
    f32x4 acc[2][2][4][2];
#pragma unroll
    for (int a = 0; a < 2; ++a)
#pragma unroll
        for (int b = 0; b < 2; ++b)
#pragma unroll
            for (int m = 0; m < 4; ++m)
#pragma unroll
                for (int n = 0; n < 2; ++n) acc[a][b][m][n] = (f32x4){0.f, 0.f, 0.f, 0.f};
    bf16x8 At[4][2], B0[2][2], B1[2][2];
    const char* cA = (const char*)g.A + (size_t)cur.pm * tstepA + (size_t)cur.z * g.azs * 2; const char* cB = (const char*)g.Bt + (size_t)cur.pn * tstepB + (size_t)cur.z * g.bzs * 2;
    PG8_STAGE(PG8_SB(0, 0), cB, voffB); PG8_STAGE(PG8_SB(0, 1), cB + hstepB, voffB); PG8_STAGE(PG8_SA(0, 0), cA, voffA); PG8_STAGE(PG8_SA(0, 1), cA + hstepA, voffA);
    if (wr == 1) PG8_BAR;
    PG8_WAIT_V(2); PG8_BAR;
    PG8_STAGE(PG8_SB(1, 0), cB + kstep, voffB); PG8_STAGE(PG8_SA(1, 0), cA + kstep, voffA); PG8_STAGE(PG8_SB(1, 1), cB + hstepB + kstep, voffB);
    PG8_WAIT_V(6); PG8_BAR;
    for (;;) {
        const bool has_next = S.next(ui + 1, nxt);
        const char* nA = has_next ? (const char*)g.A + (size_t)nxt.pm * tstepA + (size_t)nxt.z * g.azs * 2 : cA;
        const char* nB = has_next ? (const char*)g.Bt + (size_t)nxt.pn * tstepB + (size_t)nxt.z * g.bzs * 2 : cB;
        for (int t = 0; t < nt; t += 2) {
            const bool last = (t == nt - 2);
            const char* a1 = cA + (size_t)(t + 1) * kstep;
            const char* a2 = last ? nA : cA + (size_t)(t + 2) * kstep; const char* b2 = last ? nB : cB + (size_t)(t + 2) * kstep;
            const char* a3 = a2 + kstep; const char* b3 = b2 + kstep;
            PG8_LDB(B0, 0, 0); PG8_LDB(B1, 0, 1); PG8_SCHED; PG8_LDA(At, 0, 0); PG8_STAGE(PG8_SA(1, 1), a1 + hstepA, voffA);
            PG8_WAIT_V(8); PG8_WAIT_L(0); PG8_BAR; PG8_MMA(0, 0, At, B0); PG8_MMA(0, 1, At, B1); PG8_BAR; PG8_SCHED;
            PG8_LDA(At, 0, 1); PG8_STAGE(PG8_SB(0, 0), b2, voffB); PG8_STAGE(PG8_SB(0, 1), b2 + hstepB, voffB); PG8_STAGE(PG8_SA(0, 0), a2, voffA);
            PG8_WAIT_V(8); PG8_WAIT_L(0); PG8_BAR; PG8_MMA(1, 0, At, B0); PG8_MMA(1, 1, At, B1); PG8_BAR; PG8_SCHED;
            PG8_LDB(B0, 1, 0); PG8_LDB(B1, 1, 1); PG8_SCHED; PG8_LDA(At, 1, 0); PG8_STAGE(PG8_SA(0, 1), a2 + hstepA, voffA);
            PG8_WAIT_V(8); PG8_WAIT_L(0); PG8_BAR; PG8_MMA(0, 0, At, B0); PG8_MMA(0, 1, At, B1); PG8_BAR; PG8_SCHED;
            PG8_LDA(At, 1, 1); PG8_STAGE(PG8_SB(1, 0), b3, voffB); PG8_STAGE(PG8_SB(1, 1), b3 + hstepB, voffB); PG8_STAGE(PG8_SA(1, 0), a3, voffA);
            PG8_WAIT_V(8); PG8_WAIT_L(0); PG8_BAR; PG8_MMA(1, 0, At, B0); PG8_MMA(1, 1, At, B1); PG8_BAR; PG8_SCHED;
        }
        if (wr == 0) PG8_BAR;
        E(acc, cur, wr, wc, fr, fq);
        if (!has_next) break;
        if (!Epi::KEEP_ACC || nxt.z == 0)
#pragma unroll
        for (int a = 0; a < 2; ++a)
#pragma unroll
            for (int b = 0; b < 2; ++b)
#pragma unroll
                for (int m = 0; m < 4; ++m)
#pragma unroll
                    for (int n = 0; n < 2; ++n) acc[a][b][m][n] = (f32x4){0.f, 0.f, 0.f, 0.f};
        cur = nxt; cA = nA; cB = nB; ++ui;
        if (wr == 1) PG8_BAR;
    }
    PG8_WAIT_V(0);
    PG8_BAR;
#undef PG8_SA
#undef PG8_SB
#undef PG8_STAGE
#undef PG8_LDA
#undef PG8_LDB
#undef PG8_MMA
#undef PG8_WAIT_V
#undef PG8_WAIT_L
#undef PG8_BAR
#undef PG8_SCHED
}

__device__ __forceinline__ u32x4 pack8(const f32x4& v0, const f32x4& v1) { u32x4 w; w.x = cvt_pk_bf16(v0[0], v0[1]); w.y = cvt_pk_bf16(v0[2], v0[3]); w.z = cvt_pk_bf16(v1[0], v1[1]); w.w = cvt_pk_bf16(v1[2], v1[3]); return w; }
__device__ __forceinline__ float row_rstd(const float* part, int row) {
    const f32x4* p = (const f32x4*)(part + (size_t)row * 16); const f32x4 a = p[0], b = p[1], c = p[2], d = p[3];
    const float s = ((a[0] + a[1]) + (a[2] + a[3])) + ((b[0] + b[1]) + (b[2] + b[3])) + ((c[0] + c[1]) + (c[2] + c[3])) + ((d[0] + d[1]) + (d[2] + d[3]));
    return rsqrtf(s * (1.f / DM) + EPS);
}

#define MEMBAR() asm volatile("" ::: "memory")
__device__ __forceinline__ void rows_rstd(float (&rs)[2][4], const float* part, int row0, int fq) {
    f32x4 p[2][4];
#pragma unroll
    for (int ai = 0; ai < 2; ++ai)
#pragma unroll
        for (int m = 0; m < 4; ++m) p[ai][m] = *(const f32x4*)(part + (size_t)(row0 + ai * HALF + m * 16) * 16 + 4 * fq);
    MEMBAR();
#pragma unroll
    for (int ai = 0; ai < 2; ++ai)
#pragma unroll
        for (int m = 0; m < 4; ++m) { float s = (p[ai][m][0] + p[ai][m][1]) + (p[ai][m][2] + p[ai][m][3]); s += __shfl_xor(s, 16); s += __shfl_xor(s, 32); rs[ai][m] = rsqrtf(s * (1.f / DM) + EPS); }
}
#define EPI_LANE() const int tid_ = opaque_tid(); const int wid_ = __builtin_amdgcn_readfirstlane(tid_ >> 6), lane_ = tid_ & 63, wr = wid_ >> 2, wc = wid_ & 3, fr = lane_ & 15, fq = lane_ >> 4; (void)wr; (void)wc; (void)fr; (void)fq
struct EpiP1 {
    static constexpr bool KEEP_ACC = false;
    int l;
    __device__ __forceinline__ void operator()(f32x4 (&acc)[2][2][4][2], const Unit& u, int, int, int, int) const {
        EPI_LANE();
        const kargs_t ka = kargs(); unsigned char* ws = ka->ws; bf16_t* mainA = (bf16_t*)ka->out; bf16_t* mainB = (bf16_t*)(ws + WS_MB); const float* part = (const float*)(ws + WS_PART);
        const int pn = u.pn, row0 = u.pm * BM + wr * 64 + fr;
        float rs[2][4]; rows_rstd(rs, part, row0, fq);
        const int ch0 = 64 * wc + 8 * fq;
        if (pn == 27) {
            if (wc == 0 && fq == 0) {
                float* lgf = (float*)(ws + WS_LOGF);
                const f32x4 bb = *(const f32x4*)(ka->in[10] + l * 4);
#pragma unroll
                for (int ai = 0; ai < 2; ++ai)
#pragma unroll
                    for (int m = 0; m < 4; ++m) { const int row = row0 + ai * HALF + m * 16; const f32x4 v = acc[ai][0][m][0] * rs[ai][m]; f32x4 o;
                        o[0] = logsig_f(v[0] + bb[0]); o[1] = logsig_f(v[1] + bb[1]); o[2] = logsig_f(v[2] + bb[2]); o[3] = logsig_f(v[3] + bb[3]);
                        *(f32x4*)(lgf + (size_t)row * 4) = o; }
            }
            return;
        }
        if (pn == 8 || pn == 9) {
            bf16_t* dst = (pn == 8) ? mainA + A_YD : mainB + B_FK; const int pitch = (pn == 8) ? PA : PB;
            f32x4 gm[2][2];
#pragma unroll
            for (int bj = 0; bj < 2; ++bj)
#pragma unroll
                for (int n = 0; n < 2; ++n) { const int d = 32 * bj + 8 * fq + 4 * n;
                    if (pn == 8) { const f32x4 a = *(const f32x4*)(ka->in[8] + l * 64 + d), b = *(const f32x4*)(ka->in[9] + l * 64 + d); gm[bj][n] = a * b * QSCALE; } else gm[bj][n] = (f32x4){1.f, 1.f, 1.f, 1.f}; }
#pragma unroll
            for (int ai = 0; ai < 2; ++ai)
#pragma unroll
                for (int m = 0; m < 4; ++m) { const int row = row0 + ai * HALF + m * 16; const float r = rs[ai][m]; float ss = 0.f; f32x4 v[2][2];
#pragma unroll
                    for (int bj = 0; bj < 2; ++bj)
#pragma unroll
                        for (int n = 0; n < 2; ++n) { v[bj][n] = acc[ai][bj][m][n] * r; const f32x4 q = v[bj][n] * v[bj][n]; ss += (q[0] + q[1]) + (q[2] + q[3]); }
                    ss += __shfl_xor(ss, 16); ss += __shfl_xor(ss, 32);
                    const float rn = rsqrtf(ss * (1.f / 64.f) + EPS);
                    bf16_t* rowp = dst + (size_t)row * pitch + ch0;
#pragma unroll
                    for (int bj = 0; bj < 2; ++bj) *(u32x4*)(rowp + 32 * bj) = pack8(v[bj][0] * rn * gm[bj][0], v[bj][1] * rn * gm[bj][1]); }
            return;
        }
        bf16_t* dst; int pitch; int mode = 0; float sc = 1.f;
        if (pn >= 11) { dst = (bf16_t*)(ws + WS_GATES) + 256 * (pn - 11); pitch = PG; mode = 2; }
        else if (pn == 0) { dst = mainA + A_YA; pitch = PA; }
        else if (pn == 1) { dst = mainA + A_CC; pitch = PA; }
        else if (pn == 2) { dst = mainA + A_CX; pitch = PA; }
        else if (pn == 3) { dst = mainA + A_YB; pitch = PA; mode = 1; }
        else if (pn == 4) { dst = mainA + A_V; pitch = PA; mode = 1; }
        else if (pn == 5) { dst = mainA + A_YC; pitch = PA; sc = QSCALE; }
        else if (pn == 6) { dst = mainA + A_SK; pitch = PA; }
        else if (pn == 7) { dst = mainB + B_SV; pitch = PB; }
        else { dst = mainB + B_FV; pitch = PB; }
#pragma unroll
        for (int ai = 0; ai < 2; ++ai)
#pragma unroll
            for (int m = 0; m < 4; ++m) { const int row = row0 + ai * HALF + m * 16; const float r = rs[ai][m] * sc; bf16_t* rowp = dst + (size_t)row * pitch + ch0;
#pragma unroll
                for (int bj = 0; bj < 2; ++bj) { f32x4 v0 = acc[ai][bj][m][0] * r, v1 = acc[ai][bj][m][1] * r;
                    if (mode == 1) {
#pragma unroll
                        for (int e = 0; e < 4; ++e) { v0[e] = gelu_tanh_f(v0[e]); v1[e] = gelu_tanh_f(v1[e]); } }
                    else if (mode == 2) {
#pragma unroll
                        for (int e = 0; e < 4; ++e) { v0[e] = fast_sigmoid(v0[e]); v1[e] = fast_sigmoid(v1[e]); } }
                    *(u32x4*)(rowp + 32 * bj) = pack8(v0, v1); } }
    }
};
struct EpiBranch {
    static constexpr bool KEEP_ACC = true;
    int dummy;
    __device__ __forceinline__ void operator()(f32x4 (&acc)[2][2][4][2], const Unit& u, int, int, int, int) const {
        EPI_LANE();
        const kargs_t ka = kargs(); const bf16_t* gates = (const bf16_t*)(ka->ws + WS_GATES); bf16_t* merged = (bf16_t*)ka->out + A_MRG;
        const int row0 = u.pm * BM + wr * 64 + fr, col0 = u.pn * BM + wc * 32 + 8 * fq; const int z = u.z;
        const bf16_t* g0 = gates + (size_t)row0 * PG + z * DM + col0;
        if (z < 3) {
#pragma unroll
            for (int ai = 0; ai < 2; ++ai) { u32x4 gw[4][2], nw[4][2];
#pragma unroll
                for (int m = 0; m < 4; ++m)
#pragma unroll
                    for (int bj = 0; bj < 2; ++bj) { const bf16_t* p = g0 + (size_t)(ai * HALF + m * 16) * PG + bj * HALF; gw[m][bj] = *(const u32x4*)p; nw[m][bj] = *(const u32x4*)(p + DM); }
                MEMBAR();
#pragma unroll
                for (int m = 0; m < 4; ++m)
#pragma unroll
                    for (int bj = 0; bj < 2; ++bj) { const u32x4 a = gw[m][bj], n = nw[m][bj]; f32x4 s0, s1;
                        s0[0] = bf_lo(a.x) * __builtin_amdgcn_rcpf(fmaxf(bf_lo(n.x), 1e-30f)); s0[1] = bf_hi(a.x) * __builtin_amdgcn_rcpf(fmaxf(bf_hi(n.x), 1e-30f));
                        s0[2] = bf_lo(a.y) * __builtin_amdgcn_rcpf(fmaxf(bf_lo(n.y), 1e-30f)); s0[3] = bf_hi(a.y) * __builtin_amdgcn_rcpf(fmaxf(bf_hi(n.y), 1e-30f));
                        s1[0] = bf_lo(a.z) * __builtin_amdgcn_rcpf(fmaxf(bf_lo(n.z), 1e-30f)); s1[1] = bf_hi(a.z) * __builtin_amdgcn_rcpf(fmaxf(bf_hi(n.z), 1e-30f));
                        s1[2] = bf_lo(a.w) * __builtin_amdgcn_rcpf(fmaxf(bf_lo(n.w), 1e-30f)); s1[3] = bf_hi(a.w) * __builtin_amdgcn_rcpf(fmaxf(bf_hi(n.w), 1e-30f));
                        acc[ai][bj][m][0] *= s0; acc[ai][bj][m][1] *= s1; } }
        } else {
#pragma unroll
            for (int ai = 0; ai < 2; ++ai) { u32x4 gw[4][2];
#pragma unroll
                for (int m = 0; m < 4; ++m)
#pragma unroll
                    for (int bj = 0; bj < 2; ++bj) gw[m][bj] = *(const u32x4*)(g0 + (size_t)(ai * HALF + m * 16) * PG + bj * HALF);
                MEMBAR();
#pragma unroll
                for (int m = 0; m < 4; ++m)
#pragma unroll
                    for (int bj = 0; bj < 2; ++bj) { const u32x4 a = gw[m][bj]; f32x4 s0, s1;
                        s0[0] = bf_lo(a.x); s0[1] = bf_hi(a.x); s0[2] = bf_lo(a.y); s0[3] = bf_hi(a.y); s1[0] = bf_lo(a.z); s1[1] = bf_hi(a.z); s1[2] = bf_lo(a.w); s1[3] = bf_hi(a.w);
                        *(u32x4*)(merged + (size_t)(row0 + ai * HALF + m * 16) * PA + col0 + bj * HALF) = pack8(acc[ai][bj][m][0] * s0, acc[ai][bj][m][1] * s1); } }
        }
    }
};
struct EpiRes {
    static constexpr bool KEEP_ACC = false;
    int final_; bool dry;
    __device__ __forceinline__ void operator()(f32x4 (&acc)[2][2][4][2], const Unit& u, int, int, int, int) const {
        EPI_LANE();
        const kargs_t ka = kargs(); unsigned char* ws = ka->ws; bf16_t* hb = (bf16_t*)(ws + WS_HB); bf16_t* lo = (bf16_t*)(ws + WS_LO); float* part = (float*)(ws + WS_PART); float* out = ka->out;
        const int row0 = u.pm * BM + wr * 64 + fr, col0 = u.pn * BM + wc * 32 + 8 * fq;
#pragma unroll
        for (int aim = 0; aim < 4; ++aim) { const int ai = aim >> 1, mb = (aim & 1) * 2; u32x4 hw[2][2], lw[2][2];
#pragma unroll
            for (int mm = 0; mm < 2; ++mm)
#pragma unroll
                for (int bj = 0; bj < 2; ++bj) { const size_t off = (size_t)(row0 + ai * HALF + (mb + mm) * 16) * DM + col0 + bj * HALF; hw[mm][bj] = *(const u32x4*)(hb + off); lw[mm][bj] = *(const u32x4*)(lo + off); }
            MEMBAR();
#pragma unroll
            for (int mm = 0; mm < 2; ++mm) { const int m = mb + mm; const size_t row = (size_t)(row0 + ai * HALF + m * 16); float ss = 0.f;
#pragma unroll
                for (int bj = 0; bj < 2; ++bj) { const size_t off = row * DM + col0 + bj * HALF; const u32x4 h4 = hw[mm][bj], l4 = lw[mm][bj];
                    f32x4 v0 = acc[ai][bj][m][0], v1 = acc[ai][bj][m][1];
                    v0[0] += bf_lo(h4.x) + bf_lo(l4.x); v0[1] += bf_hi(h4.x) + bf_hi(l4.x); v0[2] += bf_lo(h4.y) + bf_lo(l4.y); v0[3] += bf_hi(h4.y) + bf_hi(l4.y);
                    v1[0] += bf_lo(h4.z) + bf_lo(l4.z); v1[1] += bf_hi(h4.z) + bf_hi(l4.z); v1[2] += bf_lo(h4.w) + bf_lo(l4.w); v1[3] += bf_hi(h4.w) + bf_hi(l4.w);
                    if (dry) { if (v0[0] == 1.2345e30f) part[0] = v1[3]; }
                    else if (final_) { *(f32x4*)(out + off) = v0; *(f32x4*)(out + off + 4) = v1; }
                    else {
                        const f32x4 q0 = v0 * v0, q1 = v1 * v1; ss += ((q0[0] + q0[1]) + (q0[2] + q0[3])) + ((q1[0] + q1[1]) + (q1[2] + q1[3]));
                        const u32x4 nh = pack8(v0, v1);
                        f32x4 r0, r1; r0[0] = v0[0] - bf_lo(nh.x); r0[1] = v0[1] - bf_hi(nh.x); r0[2] = v0[2] - bf_lo(nh.y); r0[3] = v0[3] - bf_hi(nh.y);
                        r1[0] = v1[0] - bf_lo(nh.z); r1[1] = v1[1] - bf_hi(nh.z); r1[2] = v1[2] - bf_lo(nh.w); r1[3] = v1[3] - bf_hi(nh.w);
                        *(u32x4*)(hb + off) = nh; *(u32x4*)(lo + off) = pack8(r0, r1); } }
                if (!final_ && !dry) { ss += __shfl_xor(ss, 16); ss += __shfl_xor(ss, 32); if (fq == 0) part[row * 16 + u.pn * 4 + wc] = ss; } } }
    }
};
struct EpiSwiglu {
    static constexpr bool KEEP_ACC = false;
    int dummy;
    __device__ __forceinline__ void operator()(f32x4 (&acc)[2][2][4][2], const Unit& u, int, int, int, int) const {
        EPI_LANE();
        const kargs_t ka = kargs(); unsigned char* ws = ka->ws; bf16_t* H = (bf16_t*)(ws + WS_GATES); const float* part = (const float*)(ws + WS_PART);
        const int row0 = u.pm * BM + wr * 64 + fr, col0 = u.pn * HALF + wc * 32 + 8 * fq;
        float rs[2][4]; rows_rstd(rs, part, row0, fq);
#pragma unroll
        for (int ai = 0; ai < 2; ++ai)
#pragma unroll
            for (int m = 0; m < 4; ++m) { const int row = row0 + ai * HALF + m * 16; const float r = rs[ai][m];
                f32x4 o[2];
#pragma unroll
                for (int n = 0; n < 2; ++n) { const f32x4 gv = acc[ai][0][m][n] * r, uv = acc[ai][1][m][n] * r;
#pragma unroll
                    for (int e = 0; e < 4; ++e) o[n][e] = gv[e] * fast_sigmoid(gv[e]) * uv[e]; }
                *(u32x4*)(H + (size_t)row * FF + col0) = pack8(o[0], o[1]); }
    }
};
}

namespace mix {
constexpr int SLOTB = 8192, L_K = 0, L_V = 2 * SLOTB, L_WS = 4 * SLOTB, L_OST = L_WS + NWAVES * 256, L_CS = L_OST + NWAVES * 4096, L_END = L_CS + SEQ * 4;
static_assert(L_END <= RING_BYTES, "mixer LDS");
typedef LAS const unsigned char* lds_cptr;
__device__ __forceinline__ int crow(int r, int hi) { return (r & 3) + 8 * (r >> 2) + 4 * hi; }
__device__ __forceinline__ void glds16(const void* gsrc, unsigned lds_dst) { unsigned keep;
    asm volatile("s_mov_b32 %0, m0\n\ts_mov_b32 m0, %2\n\ts_nop 0\n\tglobal_load_lds_dwordx4 %1, off\n\ts_mov_b32 m0, %0" : "=&s"(keep) : "v"(gsrc), "s"(lds_dst) : "memory"); }
typedef short v4i16_t __attribute__((ext_vector_type(4)));
__device__ __forceinline__ s16x4 vtr(lds_cptr p) { return __builtin_bit_cast(s16x4, __builtin_amdgcn_ds_read_tr16_b64_v4i16((LAS v4i16_t*)p)); }
#define MFMA32(a, b, c) __builtin_amdgcn_mfma_f32_32x32x16_bf16(a, b, c, 0, 0, 0)
__device__ __forceinline__ void qkt(f32x16& p0, f32x16& p1, lds_cptr kp, const bf16x8* qr, const f32x16& cinit) {
#pragma unroll
    for (int d0 = 0; d0 < 4; ++d0) {
        const bf16x8 b0 = *(const LAS bf16x8*)(kp + d0 * 2048), b1 = *(const LAS bf16x8*)(kp + d0 * 2048 + 512);
        if (d0 == 0) { p0 = MFMA32(b0, qr[0], cinit); p1 = MFMA32(b1, qr[0], cinit); }
        else { p0 = MFMA32(b0, qr[d0], p0); p1 = MFMA32(b1, qr[d0], p1); } }
}
__device__ __forceinline__ void pv(f32x16* o, lds_cptr vp, const u32x4& w0, const u32x4& w1, const u32x4& w2, const u32x4& w3) {
#pragma unroll
    for (int d0 = 0; d0 < 2; ++d0) {
        s16x4 lo[4], hi[4];
#pragma unroll
        for (int ks = 0; ks < 4; ++ks) { lo[ks] = vtr(vp + d0 * 4096 + ks * 1024); hi[ks] = vtr(vp + d0 * 4096 + ks * 1024 + 512); }
#define VPK(k) (bf16x8){lo[k][0], lo[k][1], lo[k][2], lo[k][3], hi[k][0], hi[k][1], hi[k][2], hi[k][3]}
        o[d0] = MFMA32(__builtin_bit_cast(bf16x8, w0), VPK(0), o[d0]);
        o[d0] = MFMA32(__builtin_bit_cast(bf16x8, w1), VPK(1), o[d0]);
        o[d0] = MFMA32(__builtin_bit_cast(bf16x8, w2), VPK(2), o[d0]);
        o[d0] = MFMA32(__builtin_bit_cast(bf16x8, w3), VPK(3), o[d0]);
#undef VPK
    }
}
__device__ __forceinline__ void pack_p(const f32x16& p0, const f32x16& p1, u32x4& w0, u32x4& w1, u32x4& w2, u32x4& w3) {
    w0 = (u32x4){cvt_pk_bf16(p0[0], p0[1]), cvt_pk_bf16(p0[2], p0[3]), cvt_pk_bf16(p0[4], p0[5]), cvt_pk_bf16(p0[6], p0[7])};
    w1 = (u32x4){cvt_pk_bf16(p0[8], p0[9]), cvt_pk_bf16(p0[10], p0[11]), cvt_pk_bf16(p0[12], p0[13]), cvt_pk_bf16(p0[14], p0[15])};
    w2 = (u32x4){cvt_pk_bf16(p1[0], p1[1]), cvt_pk_bf16(p1[2], p1[3]), cvt_pk_bf16(p1[4], p1[5]), cvt_pk_bf16(p1[6], p1[7])};
    w3 = (u32x4){cvt_pk_bf16(p1[8], p1[9]), cvt_pk_bf16(p1[10], p1[11]), cvt_pk_bf16(p1[12], p1[13]), cvt_pk_bf16(p1[14], p1[15])};
}
__device__ __forceinline__ float half_sum(float x) { auto rr = __builtin_amdgcn_permlane32_swap(__float_as_uint(x), __float_as_uint(x), false, false); return __uint_as_float(rr[0]) + __uint_as_float(rr[1]); }
__device__ __forceinline__ float half_max(float x) { auto rr = __builtin_amdgcn_permlane32_swap(__float_as_uint(x), __float_as_uint(x), false, false); return fmaxf(__uint_as_float(rr[0]), __uint_as_float(rr[1])); }

template <int KIND>
__device__ __forceinline__ void attn_unit(LAS unsigned char* shm, int b, int h, int qb, bool dry) {
    const int tid = opaque_tid(), lane = tid & 63, r32 = lane & 31, hi = lane >> 5; const int wid = __builtin_amdgcn_readfirstlane(tid >> 6);
    const kargs_t ka = kargs(); bf16_t* mainA = (bf16_t*)ka->out; bf16_t* mainB = (bf16_t*)(ka->ws + WS_MB); const float* lgf = (const float*)(ka->ws + WS_LOGF);
    const bf16_t* Q = mainA + (KIND ? A_YD : A_YC); constexpr int ldq = PA;
    const bf16_t* K = KIND ? mainB + B_FK : mainA + A_SK; constexpr int ldk = KIND ? PB : PA;
    const bf16_t* V = mainB + (KIND ? B_FV : B_SV); constexpr int ldv = PB;
    bf16_t* O = mainA + (KIND ? A_YD : A_YC); constexpr int ldo = PA;
    const long rowbase = (long)b * SEQ; const int q0 = qb * 256;
    const unsigned ldsb = (unsigned)(uintptr_t)shm;
    LAS float* wsf = (LAS float*)(shm + L_WS) + wid * 64;
    LAS float* cs = (LAS float*)(shm + L_CS);
    if (KIND == 1) {
        float v[4];
#pragma unroll
        for (int i = 0; i < 4; ++i) v[i] = lgf[(size_t)(rowbase + 4 * tid + i) * 4 + h] * LOG2E;
        v[1] += v[0]; v[2] += v[1]; v[3] += v[2];
        const float tot = v[3]; float sc = tot;
#pragma unroll
        for (int o = 1; o < 64; o <<= 1) { const float y = __shfl_up(sc, o); if (lane >= o) sc += y; }
        if (lane == 63) wsf[0] = sc;
        LDS_WAIT(); __builtin_amdgcn_s_barrier(); asm volatile("" ::: "memory");
        float base = 0.f;
        for (int w = 0; w < wid; ++w) base += ((LAS float*)(shm + L_WS))[w * 64];
        const float ex = base + sc - tot;
        *(LAS f32x4*)(cs + 4 * tid) = (f32x4){ex + v[0], ex + v[1], ex + v[2], ex + v[3]};
        LDS_WAIT(); __builtin_amdgcn_s_barrier(); asm volatile("" ::: "memory");
    }
    const bf16_t* Qw = Q + (rowbase + q0 + wid * 32) * ldq + h * 64;
    const bf16_t* ksrc = K + rowbase * ldk + h * 64 + (long)lane * ldk + wid * 8;
    const bf16_t* vsrc = V + rowbase * ldv + h * 64 + (long)(16 * (wid & 3) + (lane >> 2)) * ldv + (wid >> 2) * 32 + (lane & 3) * 8;
    const unsigned kdst = ldsb + L_K + wid * 1024, vdst = ldsb + L_V + wid * 1024;
#define DMA_KV(t, slot) do { glds16(ksrc + (long)(t) * 64 * ldk, (unsigned)__builtin_amdgcn_readfirstlane(kdst + (slot))); glds16(vsrc + (long)(t) * 64 * ldv, (unsigned)__builtin_amdgcn_readfirstlane(vdst + (slot))); } while (0)
    const lds_cptr kp0 = (lds_cptr)shm + L_K + hi * 1024 + r32 * 16;
    const lds_cptr vp0 = (lds_cptr)shm + L_V + ((lane >> 4) & 1) * 32 + (lane & 3) * 8 + (4 * hi + ((lane & 15) >> 2)) * 64;
    const int NT = 4 * (qb + 1), tmaxw = 4 * qb + (wid >> 1);
    DMA_KV(NT - 1, 0);
    bf16x8 qr[4];
#pragma unroll
    for (int d0 = 0; d0 < 4; ++d0) qr[d0] = *(const bf16x8*)(Qw + (long)r32 * ldq + d0 * 16 + hi * 8);
    f32x16 o[2]; o[0] = f32x16{}; o[1] = f32x16{};
    const int rrel = 32 * (wid & 1) + r32;
    float mref = 0.f, lsum = 0.f, carry = 0.f;
    float crow2 = 0.f; if (KIND == 1) crow2 = cs[q0 + wid * 32 + r32];
    for (int i = 0; i < NT; ++i) {
        const int t = NT - 1 - i, slot = (i & 1) * SLOTB;
        if (i + 1 < NT) { DMA_KV(t - 1, SLOTB - slot); asm volatile("s_waitcnt vmcnt(2)" ::: "memory"); } else { asm volatile("s_waitcnt vmcnt(0)" ::: "memory"); }
        __builtin_amdgcn_s_barrier(); asm volatile("" ::: "memory");
        if (t <= tmaxw) {
            const bool diag = (t == tmaxw);
            f32x16 p0, p1; u32x4 w0, w1, w2, w3;
            if (KIND == 1) {
                f32x16 cinit;
#pragma unroll
                for (int r = 0; r < 16; ++r) cinit[r] = crow2 - mref;
                qkt(p0, p1, kp0 + slot, qr, cinit);
                LAS const float* csb = cs + 64 * t + 4 * hi;
#pragma unroll
                for (int g = 0; g < 4; ++g) { const f32x4 c0 = *(LAS const f32x4*)(csb + 8 * g), c1 = *(LAS const f32x4*)(csb + 32 + 8 * g);
#pragma unroll
                    for (int e = 0; e < 4; ++e) { p0[4 * g + e] -= c0[e]; p1[4 * g + e] -= c1[e]; } }
                if (diag) {
#pragma unroll
                    for (int r = 0; r < 16; ++r) { const int kr = crow(r, hi); if (kr > rrel) p0[r] = -INFINITY; if (kr + 32 > rrel) p1[r] = -INFINITY; } }
                float rm = fmaxf(p0[0], p1[0]);
#pragma unroll
                for (int r = 1; r < 16; ++r) rm = fmaxf(rm, fmaxf(p0[r], p1[r]));
                rm = half_max(rm);
                if (diag || __any(rm > 8.f)) {
                    const float dl = diag ? rm : fmaxf(rm, 0.f); mref += dl;
#pragma unroll
                    for (int r = 0; r < 16; ++r) { p0[r] -= dl; p1[r] -= dl; }
                    if (!diag) { const float f = __builtin_amdgcn_exp2f(-dl); lsum *= f; if (hi == 0) wsf[r32] = f; LDS_WAIT();
#pragma unroll
                        for (int r = 0; r < 16; ++r) { const float fr_ = wsf[crow(r, hi)]; o[0][r] *= fr_; o[1][r] *= fr_; }
                        LDS_WAIT(); } }
                float sacc = 0.f;
#pragma unroll
                for (int r = 0; r < 16; ++r) { p0[r] = __builtin_amdgcn_exp2f(p0[r]); p1[r] = __builtin_amdgcn_exp2f(p1[r]); sacc += p0[r] + p1[r]; }
                lsum += sacc;
            } else {
                f32x16 z16 = f32x16{};
                qkt(p0, p1, kp0 + slot, qr, z16);
                f32x16 l0, l1;
#pragma unroll
                for (int r = 0; r < 16; ++r) {
                    { const float y = p0[r], sp = fmaxf(y, 0.f) + __builtin_amdgcn_logf(1.f + __builtin_amdgcn_exp2f(-fabsf(y))); l0[r] = -sp; p0[r] = y - sp; }
                    { const float y = p1[r], sp = fmaxf(y, 0.f) + __builtin_amdgcn_logf(1.f + __builtin_amdgcn_exp2f(-fabsf(y))); l1[r] = -sp; p1[r] = y - sp; } }
                if (diag) {
#pragma unroll
                    for (int r = 0; r < 16; ++r) { const int kr = crow(r, hi); if (kr >= rrel) { l0[r] = 0.f; p0[r] = -INFINITY; } if (kr + 32 >= rrel) { l1[r] = 0.f; p1[r] = -INFINITY; } } }
                float run = carry;
#pragma unroll
                for (int blk = 1; blk >= 0; --blk)
#pragma unroll
                    for (int g = 3; g >= 0; --g) {
                        f32x16& L = blk ? l1 : l0; f32x16& P = blk ? p1 : p0;
                        const float a0 = L[4 * g], a1 = L[4 * g + 1], a2 = L[4 * g + 2], a3 = L[4 * g + 3];
                        const float gs = (a0 + a1) + (a2 + a3), T = half_sum(gs);
                        const float base = run + (hi ? 0.f : (T - gs));
                        run += T;
                        const float t3 = base, t2 = t3 + a3, t1 = t2 + a2, t0 = t1 + a1;
                        P[4 * g + 3] = __builtin_amdgcn_exp2f(P[4 * g + 3] + t3); P[4 * g + 2] = __builtin_amdgcn_exp2f(P[4 * g + 2] + t2);
                        P[4 * g + 1] = __builtin_amdgcn_exp2f(P[4 * g + 1] + t1); P[4 * g] = __builtin_amdgcn_exp2f(P[4 * g] + t0);
                    }
                carry = run;
            }
            pack_p(p0, p1, w0, w1, w2, w3);
            pv(o, vp0 + slot, w0, w1, w2, w3);
        }
        LDS_WAIT(); __builtin_amdgcn_s_barrier(); asm volatile("" ::: "memory");
    }
#undef DMA_KV
    float rli[16];
    if (KIND == 1) {
        lsum = half_sum(lsum);
        if (hi == 0) wsf[32 + r32] = lsum; LDS_WAIT();
#pragma unroll
        for (int r = 0; r < 16; ++r) rli[r] = __builtin_amdgcn_rcpf(wsf[32 + crow(r, hi)]);
    } else {
#pragma unroll
        for (int r = 0; r < 16; ++r) rli[r] = 1.f;
    }
    bf16_t* Ow = O + (rowbase + q0 + wid * 32) * ldo + h * 64;
    { LAS bf16_t* stg = (LAS bf16_t*)(shm + L_OST) + wid * 2048;
#pragma unroll
      for (int r = 0; r < 16; ++r) { const int orow = crow(r, hi);
#pragma unroll
          for (int d0 = 0; d0 < 2; ++d0) stg[orow * 64 + d0 * 32 + r32] = (bf16_t)(cvt_pk_bf16(o[d0][r] * rli[r], 0.f) & 0xffffu); }
      LDS_WAIT();
#pragma unroll
      for (int i = 0; i < 4; ++i) { const int row = i * 8 + (lane >> 3), ch = lane & 7; const u32x4 v = *(LAS const u32x4*)(stg + row * 64 + ch * 8); if (!dry) *(u32x4*)(Ow + (long)row * ldo + ch * 8) = v; } }
    LDS_WAIT(); __builtin_amdgcn_s_barrier(); asm volatile("" ::: "memory");
}

__device__ __forceinline__ void gmlp_unit(LAS unsigned char* shm, int b, int chunk, int l, bool dry) {
    const int tid = opaque_tid(), lane = tid & 63, r32 = lane & 31, hi = lane >> 5; const int wid = __builtin_amdgcn_readfirstlane(tid >> 6);
    const kargs_t ka = kargs(); bf16_t* mainA = (bf16_t*)ka->out;
    const float* wsp = ka->in[4] + (size_t)l * 4 * 128 * 128; const float* bsp = ka->in[5] + (size_t)l * 4 * 128; const float* lng = ka->in[6] + (size_t)l * 256; const float* lnb = ka->in[7] + (size_t)l * 256;
    const long row0 = (long)b * SEQ + chunk * 128;
    { const int s = 16 * wid + (lane >> 2), g = lane & 3;
      const bf16_t* src = mainA + (row0 + s) * PA + A_V + g * 64;
      u32x4 w[8]; float x[64]; float sum = 0.f;
#pragma unroll
      for (int c = 0; c < 8; ++c) { w[c] = *(const u32x4*)(src + c * 8);
          x[8 * c] = bf_lo(w[c].x); x[8 * c + 1] = bf_hi(w[c].x); x[8 * c + 2] = bf_lo(w[c].y); x[8 * c + 3] = bf_hi(w[c].y);
          x[8 * c + 4] = bf_lo(w[c].z); x[8 * c + 5] = bf_hi(w[c].z); x[8 * c + 6] = bf_lo(w[c].w); x[8 * c + 7] = bf_hi(w[c].w); }
#pragma unroll
      for (int j = 0; j < 64; ++j) sum += x[j];
      sum += __shfl_xor(sum, 1); sum += __shfl_xor(sum, 2);
      const float mu = sum * (1.f / 256.f); float var = 0.f;
#pragma unroll
      for (int j = 0; j < 64; ++j) { x[j] -= mu; var += x[j] * x[j]; }
      var += __shfl_xor(var, 1); var += __shfl_xor(var, 2);
      const float rstd = rsqrtf(var * (1.f / 256.f) + EPS);
      const int st = s >> 6, sr = s & 63;
      LAS unsigned char* dstb = shm + (g * 2 + st) * 8192 + (sr >> 4) * 1024 + (sr & 15) * 64;
#pragma unroll
      for (int c = 0; c < 8; ++c) { f32x4 a, bq;
#pragma unroll
          for (int e = 0; e < 4; ++e) { const int ch = g * 64 + 8 * c + e; a[e] = x[8 * c + e] * rstd * lng[ch] + lnb[ch]; bq[e] = x[8 * c + 4 + e] * rstd * lng[ch + 4] + lnb[ch + 4]; }
          *(LAS u32x4*)(dstb + (c >> 2) * 4096 + (c & 3) * 16) = pg8::pack8(a, bq); }
    }
    LDS_WAIT(); __builtin_amdgcn_s_barrier(); asm volatile("" ::: "memory");
#pragma unroll 1
    for (int jj = 0; jj < 2; ++jj) {
        const int job = wid + 8 * jj, g = job & 3, tb = job >> 2, t = 32 * tb + r32;
        f32x16 o[2]; o[0] = f32x16{}; o[1] = f32x16{};
        const float* wrow = wsp + ((size_t)g * 128 + t) * 128;
        for (int st = 0; st <= (tb >> 1); ++st) {
            u32x4 w4[4];
#pragma unroll
            for (int ks = 0; ks < 4; ++ks) { f32x4 a[2];
#pragma unroll
                for (int j2 = 0; j2 < 2; ++j2) { const int s0 = 64 * st + 16 * ks + 8 * j2 + 4 * hi; a[j2] = *(const f32x4*)(wrow + s0);
#pragma unroll
                    for (int e = 0; e < 4; ++e) if (s0 + e > t) a[j2][e] = 0.f; }
                w4[ks] = pg8::pack8(a[0], a[1]); }
            const lds_cptr vp = (lds_cptr)shm + (g * 2 + st) * 8192 + ((lane >> 4) & 1) * 32 + (lane & 3) * 8 + (4 * hi + ((lane & 15) >> 2)) * 64;
            pv(o, vp, w4[0], w4[1], w4[2], w4[3]);
        }
#pragma unroll
        for (int r = 0; r < 16; ++r) { const int tt = 32 * tb + crow(r, hi); const float bb = bsp[g * 128 + tt];
#pragma unroll
            for (int d0 = 0; d0 < 2; ++d0) { bf16_t* p = mainA + (row0 + tt) * PA + A_YB + g * 64 + d0 * 32 + r32;
                const float uu = __uint_as_float((unsigned)(*p) << 16);
                if (!dry) *p = (bf16_t)(cvt_pk_bf16(uu * (o[d0][r] + bb), 0.f) & 0xffffu); } }
    }
    LDS_WAIT(); __builtin_amdgcn_s_barrier(); asm volatile("" ::: "memory");
}
__device__ __forceinline__ void conv_unit(int unit, int l, bool dry) {
    const int tid = opaque_tid(), cg = tid & 31, rg = tid >> 5;
    const kargs_t ka = kargs(); bf16_t* mainA = (bf16_t*)ka->out; const float* wconv = ka->in[3] + (size_t)l * 3 * 256;
    const int c0 = cg * 8;
    float w[3][8];
#pragma unroll
    for (int k = 0; k < 3; ++k) { const f32x4 a = *(const f32x4*)(wconv + k * 256 + c0), bq = *(const f32x4*)(wconv + k * 256 + c0 + 4);
#pragma unroll
        for (int e = 0; e < 4; ++e) { w[k][e] = a[e]; w[k][4 + e] = bq[e]; } }
    const long rbase = (long)unit * 64 + rg * 4;
    float xc[6][8];
#pragma unroll
    for (int i = 0; i < 6; ++i) { const long row = rbase - 2 + i; const bool ok = (i >= 2) || ((int)(rbase & (SEQ - 1)) + i - 2 >= 0);
        if (ok) { const u32x4 a = *(const u32x4*)(mainA + row * PA + A_CC + c0), bq = *(const u32x4*)(mainA + row * PA + A_CX + c0);
            xc[i][0] = bf_lo(a.x) * bf_lo(bq.x); xc[i][1] = bf_hi(a.x) * bf_hi(bq.x); xc[i][2] = bf_lo(a.y) * bf_lo(bq.y); xc[i][3] = bf_hi(a.y) * bf_hi(bq.y);
            xc[i][4] = bf_lo(a.z) * bf_lo(bq.z); xc[i][5] = bf_hi(a.z) * bf_hi(bq.z); xc[i][6] = bf_lo(a.w) * bf_lo(bq.w); xc[i][7] = bf_hi(a.w) * bf_hi(bq.w); }
        else {
#pragma unroll
            for (int e = 0; e < 8; ++e) xc[i][e] = 0.f; } }
#pragma unroll
    for (int i = 0; i < 4; ++i) { const long row = rbase + i; bf16_t* p = mainA + row * PA + A_YA + c0; const u32x4 cbw = *(const u32x4*)p;
        float cbv[8] = {bf_lo(cbw.x), bf_hi(cbw.x), bf_lo(cbw.y), bf_hi(cbw.y), bf_lo(cbw.z), bf_hi(cbw.z), bf_lo(cbw.w), bf_hi(cbw.w)}; f32x4 o0, o1;
#pragma unroll
        for (int e = 0; e < 4; ++e) { o0[e] = cbv[e] * (w[0][e] * xc[i][e] + w[1][e] * xc[i + 1][e] + w[2][e] * xc[i + 2][e]);
            o1[e] = cbv[4 + e] * (w[0][4 + e] * xc[i][4 + e] + w[1][4 + e] * xc[i + 1][4 + e] + w[2][4 + e] * xc[i + 2][4 + e]); }
        if (!dry) *(u32x4*)p = pg8::pack8(o0, o1); }
}
}

#define XB_TMO      128
#define XB_XCNT(j)  (256  + 64 * (j))
#define XB_XSUB(j)  (1280 + 64 * (j))
#define XB_XGEN(j)  (2304 + 64 * (j))
#define XB_TOP      3328
#define XB_TOPGEN   3392
#define XCD_BAR_WORDS 3456
#define XB_SPIN_CAP (1u << 18)
__device__ __forceinline__ unsigned xb_ld(unsigned* p)              { return __hip_atomic_load(p, __ATOMIC_RELAXED, __HIP_MEMORY_SCOPE_AGENT); }
__device__ __forceinline__ unsigned xb_add(unsigned* p, unsigned v) { return __hip_atomic_fetch_add(p, v, __ATOMIC_RELAXED, __HIP_MEMORY_SCOPE_AGENT); }
__device__ __forceinline__ unsigned xb_xcc_id() { return (unsigned)__builtin_amdgcn_s_getreg((3 << 11) | 20) & 0xFu; }
#define XB_SPIN(cond, bar) do { unsigned _sp = 0; while (cond) { __builtin_amdgcn_s_sleep(1); \
    if ((++_sp & 255u) == 0u) { if (xb_ld(&(bar)[XB_TMO])) break; if (_sp > XB_SPIN_CAP) { atomicAdd(&(bar)[XB_TMO], 1u); break; } } } } while (0)
struct XcdBarrier { unsigned* bar; unsigned x; volatile LAS unsigned* st; };
__device__ __forceinline__ XcdBarrier xcd_barrier_post(unsigned* bar, volatile LAS unsigned* st) {
    XcdBarrier b; b.bar = bar; b.x = xb_xcc_id(); b.st = st;
    if (threadIdx.x == 0) (void)xb_add(&bar[XB_XCNT(b.x)], 1u);
    return b;
}
__device__ __forceinline__ void xcd_barrier_complete(unsigned* bar, unsigned x, unsigned& nloc, unsigned& nx) {
    const unsigned G = gridDim.x * gridDim.y * gridDim.z;
    unsigned sum, cnt, mine, sp = 0u;
    for (;;) {
        sum = 0u; cnt = 0u; mine = 0u;
#pragma unroll
        for (unsigned j = 0; j < 16; ++j) { const unsigned c = xb_ld(&bar[XB_XCNT(j)]); sum += c; cnt += (c > 0u) ? 1u : 0u; mine = (j == x) ? c : mine; }
        if (sum == G) break;
        __builtin_amdgcn_s_sleep(1);
        if ((++sp & 255u) == 0u) { if (xb_ld(&bar[XB_TMO])) break; if (sp > XB_SPIN_CAP) { atomicAdd(&bar[XB_TMO], 1u); break; } }
    }
    nloc = mine > 0u ? mine : 1u; nx = cnt > 0u ? cnt : 1u;
}
__device__ __forceinline__ void xcd_barrier(const XcdBarrier& b) {
    asm volatile("s_waitcnt vmcnt(0)" ::: "memory");
    __syncthreads();
    if (threadIdx.x == 0) {
        unsigned* bar = b.bar;
        __builtin_amdgcn_s_waitcnt(0);
        unsigned nloc = b.st[0], nx = b.st[1];
        if (nloc == 0u) { xcd_barrier_complete(bar, b.x, nloc, nx); b.st[0] = nloc; b.st[1] = nx; }
        const unsigned old = xb_add(&bar[XB_XSUB(b.x)], 1u);
        const unsigned gen = old / nloc;
        if (old + 1u == (gen + 1u) * nloc) {
            __builtin_amdgcn_fence(__ATOMIC_RELEASE, "agent");
            asm volatile("s_waitcnt vmcnt(0)" ::: "memory");
            const unsigned og = xb_add(&bar[XB_TOP], 1u);
            const unsigned tg = og / nx;
            if (og + 1u == (tg + 1u) * nx) xb_add(&bar[XB_TOPGEN], 1u);
            else XB_SPIN(xb_ld(&bar[XB_TOPGEN]) == tg, bar);
            __builtin_amdgcn_fence(__ATOMIC_ACQUIRE, "agent");
            xb_add(&bar[XB_XGEN(b.x)], 1u);
            asm volatile("s_waitcnt vmcnt(0)" ::: "memory");
        } else {
            XB_SPIN(xb_ld(&bar[XB_XGEN(b.x)]) == gen, bar);
            __builtin_amdgcn_fence(__ATOMIC_ACQUIRE, "agent");
            asm volatile("s_waitcnt vmcnt(0)" ::: "memory");
        }
    }
    __syncthreads();
}

__device__ __forceinline__ float wave_sum(float v) {
#pragma unroll
    for (int o = 1; o < 64; o <<= 1) v += __shfl_xor(v, o);
    return v;
}
__device__ __forceinline__ void tr_item(const float* W, int ldw, const float* ks, bf16_t* WT, int K, int k0, int p0, int src0, int nvalid, LAS float* scr, int lane) {
#pragma unroll 8
    for (int i = 0; i < 32; ++i) { const int kk = 2 * i + (lane >> 5), n = lane & 31;
        float v = 0.f; if (n < nvalid) { v = W[(size_t)(k0 + kk) * ldw + src0 + n]; if (ks) v *= ks[k0 + kk]; }
        scr[kk * 33 + n] = v; }
    LDS_WAIT(); asm volatile("" ::: "memory");
    const int c = lane & 7;
#pragma unroll
    for (int j = 0; j < 4; ++j) { const int n = (lane >> 3) + 8 * j; const LAS float* s = scr + (8 * c) * 33 + n;
        u32x4 o; o.x = cvt_pk_bf16(s[0 * 33], s[1 * 33]); o.y = cvt_pk_bf16(s[2 * 33], s[3 * 33]); o.z = cvt_pk_bf16(s[4 * 33], s[5 * 33]); o.w = cvt_pk_bf16(s[6 * 33], s[7 * 33]);
        *(u32x4*)(WT + (size_t)(p0 + n) * K + k0 + 8 * c) = o; }
    LDS_WAIT(); asm volatile("" ::: "memory");
}

constexpr int PH_PER_LAYER = 7, N_PHASES = DEPTH * PH_PER_LAYER;

__global__ void __launch_bounds__(NWAVES * 64, 2) mk_fwd(Args args) {
    extern __shared__ __attribute__((aligned(16))) unsigned char lds_raw[];
    LAS unsigned char* lds = (LAS unsigned char*)lds_raw;
    volatile LAS unsigned* MISC = (volatile LAS unsigned*)(lds + MISC_OFF);
    const int G = gridDim.x, bx = blockIdx.x;
    { const int tid = threadIdx.x; for (int u = tid; u < (LDS_BYTES - LDSCTL_OFF) / 4; u += NWAVES * 64) ((LAS unsigned*)(lds + LDSCTL_OFF))[u] = 0u; }
    __syncthreads();
    XcdBarrier bar = xcd_barrier_post((unsigned*)(args.ws + WS_CTL) + CW_BAR, MISC + 8);
    const int lo_ph = args.ph_lo, hi_ph = args.ph_hi;
#ifndef PHMASK
#define PHMASK 0x7f
#endif
#define IN(k) (((PHMASK >> ((k) % PH_PER_LAYER)) & 1) && lo_ph <= (k) && (k) < hi_ph)
#define SEAM(k) do { if (lo_ph <= (k) && (k) + 1 < hi_ph) xcd_barrier(bar); } while (0)
#ifndef PROBE_DUP
#define PROBE_DUP 0
#endif
#define REPS(k) (((PROBE_DUP >> (k)) & 1) ? 2 : 1)

#pragma unroll 1
    for (int l = 0; l < DEPTH; ++l) {
        const int pb = l * PH_PER_LAYER;
        for (int rep = 0; rep < REPS(0); ++rep) if (IN(pb + 0)) {
            const int tid = opaque_tid(), lane = tid & 63, wave = __builtin_amdgcn_readfirstlane(tid >> 6);
            const int vcu = (G % 8 == 0) ? (bx % 8) * (G / 8) + bx / 8 : bx;
            const kargs_t ka = kargs(); unsigned char* ws = ka->ws;
            LAS float* scr = (LAS float*)(lds + wave * 16384);
            const int gw = vcu * NWAVES + wave, NGW = G * NWAVES;
            constexpr int I_IN = 16 * (NP1 / 32), I_BR = 4 * 4 * 32, I_OUT = 16 * 32, I_F1 = 16 * (NF1 / 32), I_F2 = (FF / 64) * 32;
            constexpr int NITEMS = I_IN + I_BR + I_OUT + I_F1 + I_F2;
#pragma unroll 1
            for (int it = gw; it < NITEMS; it += NGW) {
                int r = it;
                if (r < I_IN) { const int kb = r / (NP1 / 32), nb = r % (NP1 / 32), pn = nb >> 3, q = nb & 7, chb = 64 * (q & 3) + 32 * (q >> 2);
                    int src0, nvalid = 32;
                    if (pn <= 10) src0 = 256 * pn + chb; else if (pn <= 26) src0 = 2820 + 256 * (pn - 11) + chb; else { src0 = 2816; nvalid = (q == 0) ? 4 : 0; }
                    tr_item(ka->in[2] + (size_t)l * DM * NIN, NIN, ka->in[1] + (size_t)l * DM, (bf16_t*)(ws + WS_WIN), DM, 64 * kb, 32 * nb, src0, nvalid, scr, lane); continue; }
                r -= I_IN;
                if (r < I_BR) { const int z = r / 128, rr = r % 128, kb = rr / 32, nb = rr % 32;
                    tr_item(ka->in[11] + ((size_t)l * 4 + z) * 256 * DM, DM, nullptr, (bf16_t*)(ws + WS_WBR) + (size_t)z * DM * 256, 256, 64 * kb, 32 * nb, 32 * nb, 32, scr, lane); continue; }
                r -= I_BR;
                if (r < I_OUT) { const int kb = r / 32, nb = r % 32; tr_item(ka->in[12] + (size_t)l * DM * DM, DM, nullptr, (bf16_t*)(ws + WS_WOUT), DM, 64 * kb, 32 * nb, 32 * nb, 32, scr, lane); continue; }
                r -= I_OUT;
                if (r < I_F1) { const int kb = r / (NF1 / 32), nb = r % (NF1 / 32), pn = nb >> 3, q = nb & 7;
                    tr_item(ka->in[14] + (size_t)l * DM * NF1, NF1, ka->in[13] + (size_t)l * DM, (bf16_t*)(ws + WS_WF1), DM, 64 * kb, 32 * nb, ((q >> 2) ? FF : 0) + 128 * pn + 32 * (q & 3), 32, scr, lane); continue; }
                r -= I_F1;
                { const int kb = r / 32, nb = r % 32; tr_item(ka->in[15] + (size_t)l * FF * DM, DM, nullptr, (bf16_t*)(ws + WS_WF2), FF, 64 * kb, 32 * nb, 32 * nb, 32, scr, lane); }
            }
            if (l == 0) {
                const float* x = ka->in[0]; bf16_t* HB = (bf16_t*)(ws + WS_HB); bf16_t* LO = (bf16_t*)(ws + WS_LO); float* part = (float*)(ws + WS_PART);
#pragma unroll 1
                for (int m = gw; m < M; m += NGW) {
                    const f32x4* xr = (const f32x4*)(x + (size_t)m * DM) + lane; f32x4 v[4]; float s = 0.f;
#pragma unroll
                    for (int j = 0; j < 4; ++j) { v[j] = xr[64 * j]; s += (v[j][0] * v[j][0] + v[j][1] * v[j][1]) + (v[j][2] * v[j][2] + v[j][3] * v[j][3]); }
                    s = wave_sum(s);
                    u32x2* hb8 = (u32x2*)(HB + (size_t)m * DM) + lane; u32x2* lo8 = (u32x2*)(LO + (size_t)m * DM) + lane;
#pragma unroll
                    for (int j = 0; j < 4; ++j) { u32x2 hw; hw.x = cvt_pk_bf16(v[j][0], v[j][1]); hw.y = cvt_pk_bf16(v[j][2], v[j][3]);
                        u32x2 lw; lw.x = cvt_pk_bf16(v[j][0] - bf_lo(hw.x), v[j][1] - bf_hi(hw.x)); lw.y = cvt_pk_bf16(v[j][2] - bf_lo(hw.y), v[j][3] - bf_hi(hw.y));
                        hb8[64 * j] = hw; lo8[64 * j] = lw; }
                    if (lane < 16) part[(size_t)m * 16 + lane] = (lane == 0) ? s : 0.f;
                }
            }
        }
        SEAM(pb + 0);
        for (int rep = 0; rep < REPS(1); ++rep) if (IN(pb + 1)) {
            const kargs_t ka = kargs();
            pg8::Gemm g{(const bf16_t*)(ka->ws + WS_HB), (const bf16_t*)(ka->ws + WS_WIN), DM, DM, 0, 0}; pg8::StaticOrder S; S.init(M, NP1, G, bx);
            pg8::EpiP1 E{l};
            pg8::gemm_phase(lds, g, S, E);
        }
        SEAM(pb + 1);
        for (int rep = 0; rep < REPS(2); ++rep) if (IN(pb + 2)) {
            const bool dry = (REPS(2) == 2) && (rep + lo_ph == 0);
            constexpr int N_ATT = 512, N_GM = 128, N_CV = M / 64, N_ITEMS = N_ATT + N_GM + N_CV;
#pragma unroll 1
            for (;;) {
                if (threadIdx.x == 0) { const kargs_t ka = kargs(); MISC[16] = xb_add((unsigned*)(ka->ws + WS_CTL) + CW_QUEUE + 64 * (l + 2 * rep), 1u); }
                __syncthreads();
                int it = (int)MISC[16];
                __syncthreads();
                it = __builtin_amdgcn_readfirstlane(it);
                if (it >= N_ITEMS) break;
                if (it < N_ATT) { const int qb = 7 - (it >> 6), kind = (it >> 5) & 1, bh = it & 31, b = bh >> 2, h = bh & 3;
                    if (kind) mix::attn_unit<1>(lds, b, h, qb, dry); else mix::attn_unit<0>(lds, b, h, qb, dry);
                } else if (it < N_ATT + N_GM) { const int j = it - N_ATT; mix::gmlp_unit(lds, j >> 4, j & 15, l, dry); }
                else mix::conv_unit(it - N_ATT - N_GM, l, dry);
            }
        }
        SEAM(pb + 2);
        for (int rep = 0; rep < REPS(3); ++rep) if (IN(pb + 3)) {
            const kargs_t ka = kargs();
            pg8::Gemm g{(const bf16_t*)ka->out, (const bf16_t*)(ka->ws + WS_WBR), PA, 256, 256, (size_t)DM * 256}; pg8::BranchOrder S; S.s.init(M, DM, G, bx);
            pg8::EpiBranch E{0};
            pg8::gemm_phase(lds, g, S, E);
        }
        SEAM(pb + 3);
        for (int rep = 0; rep < REPS(4); ++rep) if (IN(pb + 4)) {
            const bool dry = (REPS(4) == 2) && (rep + lo_ph == 0);
            const kargs_t ka = kargs();
            pg8::Gemm g{(const bf16_t*)ka->out + A_MRG, (const bf16_t*)(ka->ws + WS_WOUT), PA, DM, 0, 0}; pg8::StaticOrder S; S.init(M, DM, G, bx);
            pg8::EpiRes E{0, dry};
            pg8::gemm_phase(lds, g, S, E);
        }
        SEAM(pb + 4);
        for (int rep = 0; rep < REPS(5); ++rep) if (IN(pb + 5)) {
            const kargs_t ka = kargs();
            pg8::Gemm g{(const bf16_t*)(ka->ws + WS_HB), (const bf16_t*)(ka->ws + WS_WF1), DM, DM, 0, 0}; pg8::StaticOrder S; S.init(M, NF1, G, bx);
            pg8::EpiSwiglu E{0};
            pg8::gemm_phase(lds, g, S, E);
        }
        SEAM(pb + 5);
        for (int rep = 0; rep < REPS(6); ++rep) if (IN(pb + 6)) {
            const bool dry = (REPS(6) == 2) && (rep + lo_ph == 0);
            const kargs_t ka = kargs();
            pg8::Gemm g{(const bf16_t*)(ka->ws + WS_GATES), (const bf16_t*)(ka->ws + WS_WF2), FF, FF, 0, 0}; pg8::StaticOrder S; S.init(M, DM, G, bx);
            pg8::EpiRes E{(l == DEPTH - 1) ? 1 : 0, dry};
            pg8::gemm_phase(lds, g, S, E);
        }
        if (l + 1 < DEPTH) SEAM(pb + 6);
    }
#undef IN
#undef SEAM
}

#ifndef MK_PER_PHASE
#define MK_PER_PHASE 0
#endif
extern "C" void kernel_launch(void* const* d_in, const int* in_sizes, int n_in, void* d_out, int out_size, void* d_ws, size_t ws_size, hipStream_t stream) {
    static int grid = 0;
    if (grid == 0) {
        if (n_in != 16 || out_size != M * DM || ws_size < WS_END) { fprintf(stderr, "kernel_launch: unexpected shapes (n_in %d out %d ws %zu)\n", n_in, out_size, ws_size); grid = -1; return; }
        int dev = 0, cus = 0, per_cu = 0;
        if (hipGetDevice(&dev) != hipSuccess || hipDeviceGetAttribute(&cus, hipDeviceAttributeMultiprocessorCount, dev) != hipSuccess) { grid = -1; return; }
        if (hipFuncSetAttribute((const void*)mk_fwd, hipFuncAttributeMaxDynamicSharedMemorySize, LDS_BYTES) != hipSuccess) { fprintf(stderr, "kernel_launch: hipFuncSetAttribute failed\n"); grid = -1; return; }
        if (hipOccupancyMaxActiveBlocksPerMultiprocessor(&per_cu, (const void*)mk_fwd, NWAVES * 64, LDS_BYTES) != hipSuccess || per_cu < 1) { fprintf(stderr, "kernel_launch: occupancy query says %d blocks per CU\n", per_cu); }
        (void)hipGetLastError();
        grid = cus;
        if (grid != 256) fprintf(stderr, "kernel_launch: %d CUs (built for 256)\n", grid);
    }
    if (grid < 0) return;
    (void)hipMemsetAsync((char*)d_ws + WS_CTL, 0, CTL_ZERO_BYTES, stream);
    Args a{};
    for (int i = 0; i < 16; ++i) a.in[i] = (const float*)d_in[i];
    a.out = (float*)d_out; a.ws = (unsigned char*)d_ws;
#if MK_PER_PHASE
    for (int p = 0; p < N_PHASES; ++p) { a.ph_lo = p; a.ph_hi = p + 1; hipLaunchKernelGGL(mk_fwd, dim3(grid), dim3(NWAVES * 64), LDS_BYTES, stream, a); }
#else
    a.ph_lo = 0; a.ph_hi = N_PHASES;
    void* kargs[] = {&a};
    hipError_t e = hipLaunchCooperativeKernel((const void*)mk_fwd, dim3(grid), dim3(NWAVES * 64), kargs, LDS_BYTES, stream);
    if (e != hipSuccess) fprintf(stderr, "kernel_launch: cooperative launch failed: %s\n", hipGetErrorString(e));
#endif
}
```

```cpp
#include <hip/hip_runtime.h>
#include <hip/hip_bf16.h>
#include <cstdio>
#include <cstdint>
#include <cstddef>

#define LAS __attribute__((address_space(3)))
#define GAS __attribute__((address_space(1)))
typedef unsigned short bf16_t;
typedef short bf16x8 __attribute__((ext_vector_type(8)));
typedef short s16x4 __attribute__((ext_vector_type(4)));
typedef float f32x4 __attribute__((ext_vector_type(4)));
typedef float f32x2 __attribute__((ext_vector_type(2)));
typedef float f32x16 __attribute__((ext_vector_type(16)));
typedef unsigned u32x4 __attribute__((ext_vector_type(4)));
typedef unsigned u32x2 __attribute__((ext_vector_type(2)));

constexpr int DM = 1024, NBATCH = 8, SEQ = 2048, M = NBATCH * SEQ, DEPTH = 2, NIN = 6916, FF = 2816;
constexpr int NP1 = 28 * 256;
constexpr int NF1 = 2 * FF;
constexpr int PA = 2048, PB = 768, PG = 4096;
constexpr int A_YA = 0  , A_YB = 256  , A_YC = 512  , A_YD = 768  , A_CC = 1024, A_CX = 1280, A_V = 1536, A_SK = 1792, A_MRG = 1024  ;
constexpr int B_SV = 0, B_FK = 256, B_FV = 512;
constexpr float LOG2E = 1.4426950408889634f;
constexpr float QSCALE = 0.125f * LOG2E;
constexpr float EPS = 1e-6f;

constexpr size_t MiB = 1u << 20;
constexpr size_t WS_CTL = 0, CTL_ZERO_BYTES = 1 * MiB;
constexpr size_t WS_WIN = 1 * MiB, WS_WBR = 15 * MiB, WS_WOUT = 17 * MiB, WS_WF1 = 19 * MiB, WS_WF2 = 30 * MiB;
constexpr size_t WS_PART = 36 * MiB, WS_LOGF = 37 * MiB, WS_HB = 38 * MiB, WS_LO = 70 * MiB, WS_MB = 102 * MiB, WS_GATES = 126 * MiB, WS_END = 254 * MiB;
static_assert(WS_WIN + (size_t)NP1 * DM * 2 <= WS_WBR && WS_WF1 + (size_t)NF1 * DM * 2 <= WS_WF2 && WS_WF2 + (size_t)DM * FF * 2 <= WS_PART, "weights map");
static_assert(WS_MB + (size_t)M * PB * 2 <= WS_GATES && WS_GATES + (size_t)M * PG * 2 <= WS_END && (size_t)M * FF * 2 <= (size_t)M * PG * 2, "activation map");
constexpr int CW_TMO = 0, CW_CODE = 1, CW_BAR = 4096, CW_QUEUE = 8192;

constexpr int RING_BYTES = 131072, LDSCTL_OFF = RING_BYTES, MISC_OFF = LDSCTL_OFF + 320, LDS_BYTES = 147456;
constexpr int NWAVES = 8;

__device__ __forceinline__ unsigned cvt_pk_bf16(float lo, float hi) { typedef __bf16 bf2 __attribute__((ext_vector_type(2))); f32x2 v = {lo, hi}; bf2 b = __builtin_convertvector(v, bf2); return __builtin_bit_cast(unsigned, b); }
__device__ __forceinline__ float bf_lo(unsigned w) { return __uint_as_float(w << 16); }
__device__ __forceinline__ float bf_hi(unsigned w) { return __uint_as_float(w & 0xffff0000u); }
__device__ __forceinline__ float fast_sigmoid(float x) { return __builtin_amdgcn_rcpf(1.f + __builtin_amdgcn_exp2f(-LOG2E * x)); }
__device__ __forceinline__ float gelu_tanh_f(float x) { const float t = x * (1.f + 0.044715f * x * x); return x * __builtin_amdgcn_rcpf(1.f + __builtin_amdgcn_exp2f(-2.302208198f * t)); }
__device__ __forceinline__ float logsig_f(float x) { return fminf(x, 0.f) - log1pf(expf(-fabsf(x))); }
#define LDS_WAIT() asm volatile("s_waitcnt lgkmcnt(0)" ::: "memory")
#define VM_WAIT() asm volatile("s_waitcnt vmcnt(0)" ::: "memory")
#define OPQ_V(x) asm volatile("" : "+v"(x))
#define OPQ_S(x) asm volatile("" : "+s"(x))
struct Args { const float* in[16]; float* out; unsigned char* ws; int ph_lo, ph_hi; };
typedef const __attribute__((address_space(4))) Args* kargs_t;
__device__ __forceinline__ kargs_t kargs() { kargs_t p = (kargs_t)__builtin_amdgcn_kernarg_segment_ptr(); OPQ_S(p); return p; }
__device__ __forceinline__ int opaque_tid() { int t = threadIdx.x; OPQ_V(t); return t; }

namespace pg8 {
constexpr int BM = 256, BK = 64, HALF = 128, HTB = HALF * BK * 2, STAGE_BYTES = 8 * HTB, NXCD = 8, WGM = 8;
__host__ __device__ __forceinline__ int lds_byte(int r, int c) { const int st = (r >> 4) * 2 + (c >> 5), rr = r & 15, cc = c & 31, ob = rr * 64 + cc * 2; return st * 1024 + (ob ^ (((ob >> 9) & 1) << 5)); }
__host__ __device__ __forceinline__ void stage_rc(int b, int& R, int& C) { const int st = b / 1024, sb = b % 1024, swz = sb ^ (((sb >> 9) & 1) << 5); R = (st >> 1) * 16 + swz / 64; C = (st & 1) * 32 + (swz % 64) / 2; }
__host__ __device__ __forceinline__ int perm32(int rho) { const int n = rho >> 4, i = rho & 15; return 8 * (i >> 2) + 4 * n + (i & 3); }

struct Unit { int pm, pn, z; };
struct Gemm { const bf16_t* A; const bf16_t* Bt; int lda, K; size_t azs, bzs; };

struct StaticOrder {
    int nM, nN, nwg, G, c;
    __host__ __device__ void init(int M_, int N_, int G_, int c_) { nM = M_ / BM; nN = N_ / BM; nwg = nM * nN; G = G_; c = c_; }
    __host__ __device__ bool next(int i, Unit& u) const {
        const long L = (long)i * G + c; if (L >= nwg) return false;
        int wgid = (int)L; { const int q = nwg / NXCD, r = nwg % NXCD, xcd = wgid % NXCD, off = wgid / NXCD; wgid = (xcd < r ? xcd * (q + 1) : r * (q + 1) + (xcd - r) * q) + off; }
        const int nig = WGM * nN, gid = wgid / nig, fm = gid * WGM, gsz = (nM - fm) < WGM ? (nM - fm) : WGM;
        u.pm = fm + ((wgid % nig) % gsz); u.pn = (wgid % nig) / gsz; u.z = 0; return true;
    }
};
struct BranchOrder {
    StaticOrder s;
    __host__ __device__ bool next(int i, Unit& u) const { if (i >= 4) return false; if (!s.next(0, u)) return false; u.z = i; return true; }
};

template <class Epi, class Sched>
__device__ __forceinline__ void gemm_phase(LAS unsigned char* lds, const Gemm g, const Sched& S, const Epi& E) {
    const int tid = opaque_tid(), wid = __builtin_amdgcn_readfirstlane(tid >> 6), lane = tid & 63, wr = wid >> 2, wc = wid & 3, fr = lane & 15, fq = lane >> 4;
    const int K = g.K, nt = K / BK;
    unsigned voffA[2], voffB[2];
#pragma unroll
    for (int i = 0; i < 2; ++i) { int R, C; stage_rc(tid * 16 + i * 8192, R, C); const int Rb = (R & ~31) + perm32(R & 31);
        voffA[i] = (unsigned)(R * g.lda + C) * 2u; voffB[i] = (unsigned)(Rb * K + C) * 2u; }
    const size_t kstep = (size_t)(BK * 2);
    const size_t hstepA = (size_t)HALF * g.lda * 2, tstepA = 2 * hstepA;
    const size_t hstepB = (size_t)HALF * K * 2, tstepB = 2 * hstepB;
    const unsigned ldsw = (unsigned)wid * 1024u;
    const int aoff = lds_byte(wr * 64 + fr, fq * 8), boff = lds_byte(wc * 32 + fr, fq * 8);
#define PG8_SA(b, h) (((b) * 2 + (h)) * HTB)
#define PG8_SB(b, h) ((4 + (b) * 2 + (h)) * HTB)
#define PG8_STAGE(bufoff, gbase, voff) do { _Pragma("unroll") for (int _i = 0; _i < 2; ++_i) \
        __builtin_amdgcn_global_load_lds((const unsigned*)((const char*)(gbase) + (voff)[_i]), (LAS unsigned*)(lds + (bufoff) + ldsw + _i * 8192), 16, 0, 0); } while (0)
#define PG8_LDA(dst, b, h) do { _Pragma("unroll") for (int m = 0; m < 4; ++m) _Pragma("unroll") for (int k = 0; k < 2; ++k) dst[m][k] = *(const LAS bf16x8*)(lds + PG8_SA(b, h) + aoff + m * 2048 + k * 1024); } while (0)
#define PG8_LDB(dst, b, h) do { _Pragma("unroll") for (int n = 0; n < 2; ++n) _Pragma("unroll") for (int k = 0; k < 2; ++k) dst[n][k] = *(const LAS bf16x8*)(lds + PG8_SB(b, h) + boff + n * 2048 + k * 1024); } while (0)
#define PG8_MMA(ai, bj, At, Bt) do { __builtin_amdgcn_s_setprio(1); _Pragma("unroll") for (int m = 0; m < 4; ++m) _Pragma("unroll") for (int n = 0; n < 2; ++n) _Pragma("unroll") for (int k = 0; k < 2; ++k) \
        acc[ai][bj][m][n] = __builtin_amdgcn_mfma_f32_16x16x32_bf16(Bt[n][k], At[m][k], acc[ai][bj][m][n], 0, 0, 0); __builtin_amdgcn_s_setprio(0); } while (0)
#define PG8_WAIT_V(n) asm volatile("s_waitcnt vmcnt(" #n ")" ::: "memory")
#define PG8_WAIT_L(n) asm volatile("s_waitcnt lgkmcnt(" #n ")" ::: "memory")
#define PG8_BAR __builtin_amdgcn_s_barrier()
#define PG8_SCHED __builtin_amdgcn_sched_barrier(0)
    Unit cur, nxt; int ui = 0;
    if (!S.next(0, cur)) return;
    f32x4 acc[2][2][4][2];
#pragma unroll
    for (int a = 0; a < 2; ++a)
#pragma unroll
        for (int b = 0; b < 2; ++b)
#pragma unroll
            for (int m = 0; m < 4; ++m)
#pragma unroll
                for (int n = 0; n < 2; ++n) acc[a][b][m][n] = (f32x4){0.f, 0.f, 0.f, 0.f};
    bf16x8 At[4][2], B0[2][2], B1[2][2];
    const char* cA = (const char*)g.A + (size_t)cur.pm * tstepA + (size_t)cur.z * g.azs * 2; const char* cB = (const char*)g.Bt + (size_t)cur.pn * tstepB + (size_t)cur.z * g.bzs * 2;
    PG8_STAGE(PG8_SB(0, 0), cB, voffB); PG8_STAGE(PG8_SB(0, 1), cB + hstepB, voffB); PG8_STAGE(PG8_SA(0, 0), cA, voffA); PG8_STAGE(PG8_SA(0, 1), cA + hstepA, voffA);
    if (wr == 1) PG8_BAR;
    PG8_WAIT_V(2); PG8_BAR;
    PG8_STAGE(PG8_SB(1, 0), cB + kstep, voffB); PG8_STAGE(PG8_SA(1, 0), cA + kstep, voffA); PG8_STAGE(PG8_SB(1, 1), cB + hstepB + kstep, voffB);
    PG8_WAIT_V(6); PG8_BAR;
    for (;;) {
        const bool has_next = S.next(ui + 1, nxt);
        const char* nA = has_next ? (const char*)g.A + (size_t)nxt.pm * tstepA + (size_t)nxt.z * g.azs * 2 : cA;
        const char* nB = has_next ? (const char*)g.Bt + (size_t)nxt.pn * tstepB + (size_t)nxt.z * g.bzs * 2 : cB;
        for (int t = 0; t < nt; t += 2) {
            const bool last = (t == nt - 2);
            const char* a1 = cA + (size_t)(t + 1) * kstep;
            const char* a2 = last ? nA : cA + (size_t)(t + 2) * kstep; const char* b2 = last ? nB : cB + (size_t)(t + 2) * kstep;
            const char* a3 = a2 + kstep; const char* b3 = b2 + kstep;
            PG8_LDB(B0, 0, 0); PG8_LDB(B1, 0, 1); PG8_SCHED; PG8_LDA(At, 0, 0); PG8_STAGE(PG8_SA(1, 1), a1 + hstepA, voffA);
            PG8_WAIT_V(8); PG8_WAIT_L(0); PG8_BAR; PG8_MMA(0, 0, At, B0); PG8_MMA(0, 1, At, B1); PG8_BAR; PG8_SCHED;
            PG8_LDA(At, 0, 1); PG8_STAGE(PG8_SB(0, 0), b2, voffB); PG8_STAGE(PG8_SB(0, 1), b2 + hstepB, voffB); PG8_STAGE(PG8_SA(0, 0), a2, voffA);
            PG8_WAIT_V(8); PG8_WAIT_L(0); PG8_BAR; PG8_MMA(1, 0, At, B0); PG8_MMA(1, 1, At, B1); PG8_BAR; PG8_SCHED;
            PG8_LDB(B0, 1, 0); PG8_LDB(B1, 1, 1); PG8_SCHED; PG8_LDA(At, 1, 0); PG8_STAGE(PG8_SA(0, 1), a2 + hstepA, voffA);
            PG8_WAIT_V(8); PG8_WAIT_L(0); PG8_BAR; PG8_MMA(0, 0, At, B0); PG8_MMA(0, 1, At, B1); PG8_BAR; PG8_SCHED;
            PG8_LDA(At, 1, 1); PG8_STAGE(PG8_SB(1, 0), b3, voffB); PG8_STAGE(PG8_SB(1, 1), b3 + hstepB, voffB); PG8_STAGE(PG8_SA(1, 0), a3, voffA);
            PG8_WAIT_V(8); PG8_WAIT_L(0); PG8_BAR; PG8_MMA(1, 0, At, B0); PG8_MMA(1, 1, At, B1); PG8_BAR; PG8_SCHED;
        }
        if (wr == 0) PG8_BAR;
        E(acc, cur, wr, wc, fr, fq);
        if (!has_next) break;
        if (!Epi::KEEP_ACC || nxt.z == 0)
#pragma unroll
        for (int a = 0; a < 2; ++a)
#pragma unroll
            for (int b = 0; b < 2; ++b)
#pragma unroll
                for (int m = 0; m < 4; ++m)
#pragma unroll
                    for (int n = 0; n < 2; ++n) acc[a][b][m][n] = (f32x4){0.f, 0.f, 0.f, 0.f};
        cur = nxt; cA = nA; cB = nB; ++ui;
        if (wr == 1) PG8_BAR;
    }
    PG8_WAIT_V(0);
    PG8_BAR;
#undef PG8_SA
#undef PG8_SB
#undef PG8_STAGE
#undef PG8_LDA
#undef PG8_LDB
#undef PG8_MMA
#undef PG8_WAIT_V
#undef PG8_WAIT_L
#undef PG8_BAR
#undef PG8_SCHED
}

__device__ __forceinline__ u32x4 pack8(const f32x4& v0, const f32x4& v1) { u32x4 w; w.x = cvt_pk_bf16(v0[0], v0[1]); w.y = cvt_pk_bf16(v0[2], v0[3]); w.z = cvt_pk_bf16(v1[0], v1[1]); w.w = cvt_pk_bf16(v1[2], v1[3]); return w; }
__device__ __forceinline__ float row_rstd(const float* part, int row) {
    const f32x4* p = (const f32x4*)(part + (size_t)row * 16); const f32x4 a = p[0], b = p[1], c = p[2], d = p[3];
    const float s = ((a[0] + a[1]) + (a[2] + a[3])) + ((b[0] + b[1]) + (b[2] + b[3])) + ((c[0] + c[1]) + (c[2] + c[3])) + ((d[0] + d[1]) + (d[2] + d[3]));
    return rsqrtf(s * (1.f / DM) + EPS);
}

#define MEMBAR() asm volatile("" ::: "memory")
__device__ __forceinline__ void rows_rstd(float (&rs)[2][4], const float* part, int row0, int fq) {
    f32x4 p[2][4];
#pragma unroll
    for (int ai = 0; ai < 2; ++ai)
#pragma unroll
        for (int m = 0; m < 4; ++m) p[ai][m] = *(const f32x4*)(part + (size_t)(row0 + ai * HALF + m * 16) * 16 + 4 * fq);
    MEMBAR();
#pragma unroll
    for (int ai = 0; ai < 2; ++ai)
#pragma unroll
        for (int m = 0; m < 4; ++m) { float s = (p[ai][m][0] + p[ai][m][1]) + (p[ai][m][2] + p[ai][m][3]); s += __shfl_xor(s, 16); s += __shfl_xor(s, 32); rs[ai][m] = rsqrtf(s * (1.f / DM) + EPS); }
}
#define EPI_LANE() const int tid_ = opaque_tid(); const int wid_ = __builtin_amdgcn_readfirstlane(tid_ >> 6), lane_ = tid_ & 63, wr = wid_ >> 2, wc = wid_ & 3, fr = lane_ & 15, fq = lane_ >> 4; (void)wr; (void)wc; (void)fr; (void)fq
struct EpiP1 {
    static constexpr bool KEEP_ACC = false;
    int l;
    __device__ __forceinline__ void operator()(f32x4 (&acc)[2][2][4][2], const Unit& u, int, int, int, int) const {
        EPI_LANE();
        const kargs_t ka = kargs(); unsigned char* ws = ka->ws; bf16_t* mainA = (bf16_t*)ka->out; bf16_t* mainB = (bf16_t*)(ws + WS_MB); const float* part = (const float*)(ws + WS_PART);
        const int pn = u.pn, row0 = u.pm * BM + wr * 64 + fr;
        float rs[2][4]; rows_rstd(rs, part, row0, fq);
        const int ch0 = 64 * wc + 8 * fq;
        if (pn == 27) {
            if (wc == 0 && fq == 0) {
                float* lgf = (float*)(ws + WS_LOGF);
                const f32x4 bb = *(const f32x4*)(ka->in[10] + l * 4);
#pragma unroll
                for (int ai = 0; ai < 2; ++ai)
#pragma unroll
                    for (int m = 0; m < 4; ++m) { const int row = row0 + ai * HALF + m * 16; const f32x4 v = acc[ai][0][m][0] * rs[ai][m]; f32x4 o;
                        o[0] = logsig_f(v[0] + bb[0]); o[1] = logsig_f(v[1] + bb[1]); o[2] = logsig_f(v[2] + bb[2]); o[3] = logsig_f(v[3] + bb[3]);
                        *(f32x4*)(lgf + (size_t)row * 4) = o; }
            }
            return;
        }
        if (pn == 8 || pn == 9) {
            bf16_t* dst = (pn == 8) ? mainA + A_YD : mainB + B_FK; const int pitch = (pn == 8) ? PA : PB;
            f32x4 gm[2][2];
#pragma unroll
            for (int bj = 0; bj < 2; ++bj)
#pragma unroll
                for (int n = 0; n < 2; ++n) { const int d = 32 * bj + 8 * fq + 4 * n;
                    if (pn == 8) { const f32x4 a = *(const f32x4*)(ka->in[8] + l * 64 + d), b = *(const f32x4*)(ka->in[9] + l * 64 + d); gm[bj][n] = a * b * QSCALE; } else gm[bj][n] = (f32x4){1.f, 1.f, 1.f, 1.f}; }
#pragma unroll
            for (int ai = 0; ai < 2; ++ai)
#pragma unroll
                for (int m = 0; m < 4; ++m) { const int row = row0 + ai * HALF + m * 16; const float r = rs[ai][m]; float ss = 0.f; f32x4 v[2][2];
#pragma unroll
                    for (int bj = 0; bj < 2; ++bj)
#pragma unroll
                        for (int n = 0; n < 2; ++n) { v[bj][n] = acc[ai][bj][m][n] * r; const f32x4 q = v[bj][n] * v[bj][n]; ss += (q[0] + q[1]) + (q[2] + q[3]); }
                    ss += __shfl_xor(ss, 16); ss += __shfl_xor(ss, 32);
                    const float rn = rsqrtf(ss * (1.f / 64.f) + EPS);
                    bf16_t* rowp = dst + (size_t)row * pitch + ch0;
#pragma unroll
                    for (int bj = 0; bj < 2; ++bj) *(u32x4*)(rowp + 32 * bj) = pack8(v[bj][0] * rn * gm[bj][0], v[bj][1] * rn * gm[bj][1]); }
            return;
        }
        bf16_t* dst; int pitch; int mode = 0; float sc = 1.f;
        if (pn >= 11) { dst = (bf16_t*)(ws + WS_GATES) + 256 * (pn - 11); pitch = PG; mode = 2; }
        else if (pn == 0) { dst = mainA + A_YA; pitch = PA; }
        else if (pn == 1) { dst = mainA + A_CC; pitch = PA; }
        else if (pn == 2) { dst = mainA + A_CX; pitch = PA; }
        else if (pn == 3) { dst = mainA + A_YB; pitch = PA; mode = 1; }
        else if (pn == 4) { dst = mainA + A_V; pitch = PA; mode = 1; }
        else if (pn == 5) { dst = mainA + A_YC; pitch = PA; sc = QSCALE; }
        else if (pn == 6) { dst = mainA + A_SK; pitch = PA; }
        else if (pn == 7) { dst = mainB + B_SV; pitch = PB; }
        else { dst = mainB + B_FV; pitch = PB; }
#pragma unroll
        for (int ai = 0; ai < 2; ++ai)
#pragma unroll
            for (int m = 0; m < 4; ++m) { const int row = row0 + ai * HALF + m * 16; const float r = rs[ai][m] * sc; bf16_t* rowp = dst + (size_t)row * pitch + ch0;
#pragma unroll
                for (int bj = 0; bj < 2; ++bj) { f32x4 v0 = acc[ai][bj][m][0] * r, v1 = acc[ai][bj][m][1] * r;
                    if (mode == 1) {
#pragma unroll
                        for (int e = 0; e < 4; ++e) { v0[e] = gelu_tanh_f(v0[e]); v1[e] = gelu_tanh_f(v1[e]); } }
                    else if (mode == 2) {
#pragma unroll
                        for (int e = 0; e < 4; ++e) { v0[e] = fast_sigmoid(v0[e]); v1[e] = fast_sigmoid(v1[e]); } }
                    *(u32x4*)(rowp + 32 * bj) = pack8(v0, v1); } }
    }
};
struct EpiBranch {
    static constexpr bool KEEP_ACC = true;
    int dummy;
    __device__ __forceinline__ void operator()(f32x4 (&acc)[2][2][4][2], const Unit& u, int, int, int, int) const {
        EPI_LANE();
        const kargs_t ka = kargs(); const bf16_t* gates = (const bf16_t*)(ka->ws + WS_GATES); bf16_t* merged = (bf16_t*)ka->out + A_MRG;
        const int row0 = u.pm * BM + wr * 64 + fr, col0 = u.pn * BM + wc * 32 + 8 * fq; const int z = u.z;
        const bf16_t* g0 = gates + (size_t)row0 * PG + z * DM + col0;
        if (z < 3) {
#pragma unroll
            for (int ai = 0; ai < 2; ++ai) { u32x4 gw[4][2], nw[4][2];
#pragma unroll
                for (int m = 0; m < 4; ++m)
#pragma unroll
                    for (int bj = 0; bj < 2; ++bj) { const bf16_t* p = g0 + (size_t)(ai * HALF + m * 16) * PG + bj * HALF; gw[m][bj] = *(const u32x4*)p; nw[m][bj] = *(const u32x4*)(p + DM); }
                MEMBAR();
#pragma unroll
                for (int m = 0; m < 4; ++m)
#pragma unroll
                    for (int bj = 0; bj < 2; ++bj) { const u32x4 a = gw[m][bj], n = nw[m][bj]; f32x4 s0, s1;
                        s0[0] = bf_lo(a.x) * __builtin_amdgcn_rcpf(fmaxf(bf_lo(n.x), 1e-30f)); s0[1] = bf_hi(a.x) * __builtin_amdgcn_rcpf(fmaxf(bf_hi(n.x), 1e-30f));
                        s0[2] = bf_lo(a.y) * __builtin_amdgcn_rcpf(fmaxf(bf_lo(n.y), 1e-30f)); s0[3] = bf_hi(a.y) * __builtin_amdgcn_rcpf(fmaxf(bf_hi(n.y), 1e-30f));
                        s1[0] = bf_lo(a.z) * __builtin_amdgcn_rcpf(fmaxf(bf_lo(n.z), 1e-30f)); s1[1] = bf_hi(a.z) * __builtin_amdgcn_rcpf(fmaxf(bf_hi(n.z), 1e-30f));
                        s1[2] = bf_lo(a.w) * __builtin_amdgcn_rcpf(fmaxf(bf_lo(n.w), 1e-30f)); s1[3] = bf_hi(a.w) * __builtin_amdgcn_rcpf(fmaxf(bf_hi(n.w), 1e-30f));
                        acc[ai][bj][m][0] *= s0; acc[ai][bj][m][1] *= s1; } }
        } else {
#pragma unroll
            for (int ai = 0; ai < 2; ++ai) { u32x4 gw[4][2];
#pragma unroll
                for (int m = 0; m < 4; ++m)
#pragma unroll
                    for (int bj = 0; bj < 2; ++bj) gw[m][bj] = *(const u32x4*)(g0 + (size_t)(ai * HALF + m * 16) * PG + bj * HALF);
                MEMBAR();
#pragma unroll
                for (int m = 0; m < 4; ++m)
#pragma unroll
                    for (int bj = 0; bj < 2; ++bj) { const u32x4 a = gw[m][bj]; f32x4 s0, s1;
                        s0[0] = bf_lo(a.x); s0[1] = bf_hi(a.x); s0[2] = bf_lo(a.y); s0[3] = bf_hi(a.y); s1[0] = bf_lo(a.z); s1[1] = bf_hi(a.z); s1[2] = bf_lo(a.w); s1[3] = bf_hi(a.w);
                        *(u32x4*)(merged + (size_t)(row0 + ai * HALF + m * 16) * PA + col0 + bj * HALF) = pack8(acc[ai][bj][m][0] * s0, acc[ai][bj][m][1] * s1); } }
        }
    }
};
struct EpiRes {
    static constexpr bool KEEP_ACC = false;
    int final_; bool dry;
    __device__ __forceinline__ void operator()(f32x4 (&acc)[2][2][4][2], const Unit& u, int, int, int, int) const {
        EPI_LANE();
        const kargs_t ka = kargs(); unsigned char* ws = ka->ws; bf16_t* hb = (bf16_t*)(ws + WS_HB); bf16_t* lo = (bf16_t*)(ws + WS_LO); float* part = (float*)(ws + WS_PART); float* out = ka->out;
        const int row0 = u.pm * BM + wr * 64 + fr, col0 = u.pn * BM + wc * 32 + 8 * fq;
#pragma unroll
        for (int aim = 0; aim < 4; ++aim) { const int ai = aim >> 1, mb = (aim & 1) * 2; u32x4 hw[2][2], lw[2][2];
#pragma unroll
            for (int mm = 0; mm < 2; ++mm)
#pragma unroll
                for (int bj = 0; bj < 2; ++bj) { const size_t off = (size_t)(row0 + ai * HALF + (mb + mm) * 16) * DM + col0 + bj * HALF; hw[mm][bj] = *(const u32x4*)(hb + off); lw[mm][bj] = *(const u32x4*)(lo + off); }
            MEMBAR();
#pragma unroll
            for (int mm = 0; mm < 2; ++mm) { const int m = mb + mm; const size_t row = (size_t)(row0 + ai * HALF + m * 16); float ss = 0.f;
#pragma unroll
                for (int bj = 0; bj < 2; ++bj) { const size_t off = row * DM + col0 + bj * HALF; const u32x4 h4 = hw[mm][bj], l4 = lw[mm][bj];
                    f32x4 v0 = acc[ai][bj][m][0], v1 = acc[ai][bj][m][1];
                    v0[0] += bf_lo(h4.x) + bf_lo(l4.x); v0[1] += bf_hi(h4.x) + bf_hi(l4.x); v0[2] += bf_lo(h4.y) + bf_lo(l4.y); v0[3] += bf_hi(h4.y) + bf_hi(l4.y);
                    v1[0] += bf_lo(h4.z) + bf_lo(l4.z); v1[1] += bf_hi(h4.z) + bf_hi(l4.z); v1[2] += bf_lo(h4.w) + bf_lo(l4.w); v1[3] += bf_hi(h4.w) + bf_hi(l4.w);
                    if (dry) { if (v0[0] == 1.2345e30f) part[0] = v1[3]; }
                    else if (final_) { *(f32x4*)(out + off) = v0; *(f32x4*)(out + off + 4) = v1; }
                    else {
                        const f32x4 q0 = v0 * v0, q1 = v1 * v1; ss += ((q0[0] + q0[1]) + (q0[2] + q0[3])) + ((q1[0] + q1[1]) + (q1[2] + q1[3]));
                        const u32x4 nh = pack8(v0, v1);
                        f32x4 r0, r1; r0[0] = v0[0] - bf_lo(nh.x); r0[1] = v0[1] - bf_hi(nh.x); r0[2] = v0[2] - bf_lo(nh.y); r0[3] = v0[3] - bf_hi(nh.y);
                        r1[0] = v1[0] - bf_lo(nh.z); r1[1] = v1[1] - bf_hi(nh.z); r1[2] = v1[2] - bf_lo(nh.w); r1[3] = v1[3] - bf_hi(nh.w);
                        *(u32x4*)(hb + off) = nh; *(u32x4*)(lo + off) = pack8(r0, r1); } }
                if (!final_ && !dry) { ss += __shfl_xor(ss, 16); ss += __shfl_xor(ss, 32); if (fq == 0) part[row * 16 + u.pn * 4 + wc] = ss; } } }
    }
};
struct EpiSwiglu {
    static constexpr bool KEEP_ACC = false;
    int dummy;
    __device__ __forceinline__ void operator()(f32x4 (&acc)[2][2][4][2], const Unit& u, int, int, int, int) const {
        EPI_LANE();
        const kargs_t ka = kargs(); unsigned char* ws = ka->ws; bf16_t* H = (bf16_t*)(ws + WS_GATES); const float* part = (const float*)(ws + WS_PART);
        const int row0 = u.pm * BM + wr * 64 + fr, col0 = u.pn * HALF + wc * 32 + 8 * fq;
        float rs[2][4]; rows_rstd(rs, part, row0, fq);
#pragma unroll
        for (int ai = 0; ai < 2; ++ai)
#pragma unroll
            for (int m = 0; m < 4; ++m) { const int row = row0 + ai * HALF + m * 16; const float r = rs[ai][m];
                f32x4 o[2];
#pragma unroll
                for (int n = 0; n < 2; ++n) { const f32x4 gv = acc[ai][0][m][n] * r, uv = acc[ai][1][m][n] * r;
#pragma unroll
                    for (int e = 0; e < 4; ++e) o[n][e] = gv[e] * fast_sigmoid(gv[e]) * uv[e]; }
                *(u32x4*)(H + (size_t)row * FF + col0) = pack8(o[0], o[1]); }
    }
};
}

namespace mix {
constexpr int SLOTB = 8192, L_K = 0, L_V = 2 * SLOTB, L_WS = 4 * SLOTB, L_OST = L_WS + NWAVES * 256, L_CS = L_OST + NWAVES * 4096, L_FLG = L_CS + SEQ * 4, L_END = L_FLG + 64;
static_assert(L_END <= RING_BYTES, "mixer LDS");
typedef LAS const unsigned char* lds_cptr;
__device__ __forceinline__ int crow(int r, int hi) { return (r & 3) + 8 * (r >> 2) + 4 * hi; }
__device__ __forceinline__ void glds16(const void* gsrc, unsigned lds_dst) { unsigned keep;
    asm volatile("s_mov_b32 %0, m0\n\ts_mov_b32 m0, %2\n\ts_nop 0\n\tglobal_load_lds_dwordx4 %1, off\n\ts_mov_b32 m0, %0" : "=&s"(keep) : "v"(gsrc), "s"(lds_dst) : "memory"); }
typedef short v4i16_t __attribute__((ext_vector_type(4)));
__device__ __forceinline__ s16x4 vtr(lds_cptr p) { return __builtin_bit_cast(s16x4, __builtin_amdgcn_ds_read_tr16_b64_v4i16((LAS v4i16_t*)p)); }
#define MFMA32(a, b, c) __builtin_amdgcn_mfma_f32_32x32x16_bf16(a, b, c, 0, 0, 0)
__device__ __forceinline__ void qkt(f32x16& p0, f32x16& p1, lds_cptr kp, const bf16x8* qr, const f32x16& cinit) {
#pragma unroll
    for (int d0 = 0; d0 < 4; ++d0) {
        const bf16x8 b0 = *(const LAS bf16x8*)(kp + d0 * 2048), b1 = *(const LAS bf16x8*)(kp + d0 * 2048 + 512);
        if (d0 == 0) { p0 = MFMA32(b0, qr[0], cinit); p1 = MFMA32(b1, qr[0], cinit); }
        else { p0 = MFMA32(b0, qr[d0], p0); p1 = MFMA32(b1, qr[d0], p1); } }
}
__device__ __forceinline__ void pv(f32x16* o, lds_cptr vp, const u32x4& w0, const u32x4& w1, const u32x4& w2, const u32x4& w3) {
#pragma unroll
    for (int d0 = 0; d0 < 2; ++d0) {
        s16x4 lo[4], hi[4];
#pragma unroll
        for (int ks = 0; ks < 4; ++ks) { lo[ks] = vtr(vp + d0 * 4096 + ks * 1024); hi[ks] = vtr(vp + d0 * 4096 + ks * 1024 + 512); }
#define VPK(k) (bf16x8){lo[k][0], lo[k][1], lo[k][2], lo[k][3], hi[k][0], hi[k][1], hi[k][2], hi[k][3]}
        o[d0] = MFMA32(__builtin_bit_cast(bf16x8, w0), VPK(0), o[d0]);
        o[d0] = MFMA32(__builtin_bit_cast(bf16x8, w1), VPK(1), o[d0]);
        o[d0] = MFMA32(__builtin_bit_cast(bf16x8, w2), VPK(2), o[d0]);
        o[d0] = MFMA32(__builtin_bit_cast(bf16x8, w3), VPK(3), o[d0]);
#undef VPK
    }
}
__device__ __forceinline__ void pack_p(const f32x16& p0, const f32x16& p1, u32x4& w0, u32x4& w1, u32x4& w2, u32x4& w3) {
    w0 = (u32x4){cvt_pk_bf16(p0[0], p0[1]), cvt_pk_bf16(p0[2], p0[3]), cvt_pk_bf16(p0[4], p0[5]), cvt_pk_bf16(p0[6], p0[7])};
    w1 = (u32x4){cvt_pk_bf16(p0[8], p0[9]), cvt_pk_bf16(p0[10], p0[11]), cvt_pk_bf16(p0[12], p0[13]), cvt_pk_bf16(p0[14], p0[15])};
    w2 = (u32x4){cvt_pk_bf16(p1[0], p1[1]), cvt_pk_bf16(p1[2], p1[3]), cvt_pk_bf16(p1[4], p1[5]), cvt_pk_bf16(p1[6], p1[7])};
    w3 = (u32x4){cvt_pk_bf16(p1[8], p1[9]), cvt_pk_bf16(p1[10], p1[11]), cvt_pk_bf16(p1[12], p1[13]), cvt_pk_bf16(p1[14], p1[15])};
}
__device__ __forceinline__ float half_sum(float x) { auto rr = __builtin_amdgcn_permlane32_swap(__float_as_uint(x), __float_as_uint(x), false, false); return __uint_as_float(rr[0]) + __uint_as_float(rr[1]); }
__device__ __forceinline__ float half_max(float x) { auto rr = __builtin_amdgcn_permlane32_swap(__float_as_uint(x), __float_as_uint(x), false, false); return fmaxf(__uint_as_float(rr[0]), __uint_as_float(rr[1])); }

template <int KIND>
__device__ __forceinline__ void attn_unit(LAS unsigned char* shm, int b, int h, int qb, int l, bool dry) {
    const int tid = opaque_tid(), lane = tid & 63, r32 = lane & 31, hi = lane >> 5; const int wid = __builtin_amdgcn_readfirstlane(tid >> 6);
    const kargs_t ka = kargs(); bf16_t* mainA = (bf16_t*)ka->out; bf16_t* mainB = (bf16_t*)(ka->ws + WS_MB); const float* lgf = (const float*)(ka->ws + WS_LOGF);
    const bf16_t* Q = mainA + (KIND ? A_YD : A_YC); constexpr int ldq = PA;
    const bf16_t* K = KIND ? mainB + B_FK : mainA + A_SK; constexpr int ldk = KIND ? PB : PA;
    const bf16_t* V = mainB + (KIND ? B_FV : B_SV); constexpr int ldv = PB;
    bf16_t* O = mainA + (KIND ? A_YD : A_YC); constexpr int ldo = PA;
    const long rowbase = (long)b * SEQ; const int q0 = qb * 256;
    const unsigned ldsb = (unsigned)(uintptr_t)shm;
    LAS float* wsf = (LAS float*)(shm + L_WS) + wid * 64;
    LAS float* cs = (LAS float*)(shm + L_CS);
    if (KIND == 1) {
        float v[4];
#pragma unroll
        for (int i = 0; i < 4; ++i) v[i] = lgf[(size_t)(rowbase + 4 * tid + i) * 4 + h] * LOG2E;
        v[1] += v[0]; v[2] += v[1]; v[3] += v[2];
        const float tot = v[3]; float sc = tot;
#pragma unroll
        for (int o = 1; o < 64; o <<= 1) { const float y = __shfl_up(sc, o); if (lane >= o) sc += y; }
        if (lane == 63) wsf[0] = sc;
        LDS_WAIT(); __builtin_amdgcn_s_barrier(); asm volatile("" ::: "memory");
        float base = 0.f;
        for (int w = 0; w < wid; ++w) base += ((LAS float*)(shm + L_WS))[w * 64];
        const float ex = base + sc - tot;
        *(LAS f32x4*)(cs + 4 * tid) = (f32x4){ex + v[0], ex + v[1], ex + v[2], ex + v[3]};
        LDS_WAIT(); __builtin_amdgcn_s_barrier(); asm volatile("" ::: "memory");
    }
    const bf16_t* Qw = Q + (rowbase + q0 + wid * 32) * ldq + h * 64;
    const bf16_t* ksrc = K + rowbase * ldk + h * 64 + (long)lane * ldk + wid * 8;
    const bf16_t* vsrc = V + rowbase * ldv + h * 64 + (long)(16 * (wid & 3) + (lane >> 2)) * ldv + (wid >> 2) * 32 + (lane & 3) * 8;
    const unsigned kdst = ldsb + L_K + wid * 1024, vdst = ldsb + L_V + wid * 1024;
#define DMA_KV(t, slot) do { glds16(ksrc + (long)(t) * 64 * ldk, (unsigned)__builtin_amdgcn_readfirstlane(kdst + (slot))); glds16(vsrc + (long)(t) * 64 * ldv, (unsigned)__builtin_amdgcn_readfirstlane(vdst + (slot))); } while (0)
    const lds_cptr kp0 = (lds_cptr)shm + L_K + hi * 1024 + r32 * 16;
    const lds_cptr vp0 = (lds_cptr)shm + L_V + ((lane >> 4) & 1) * 32 + (lane & 3) * 8 + (4 * hi + ((lane & 15) >> 2)) * 64;
    const int NT = 4 * (qb + 1), tmaxw = 4 * qb + (wid >> 1);
    DMA_KV(NT - 1, 0);
    bf16x8 qr[4];
#pragma unroll
    for (int d0 = 0; d0 < 4; ++d0) qr[d0] = *(const bf16x8*)(Qw + (long)r32 * ldq + d0 * 16 + hi * 8);
    f32x16 o[2]; o[0] = f32x16{}; o[1] = f32x16{};
    const int rrel = 32 * (wid & 1) + r32;
    float mref = 0.f, lsum = 0.f, carry = 0.f;
    float crow2 = 0.f; if (KIND == 1) crow2 = cs[q0 + wid * 32 + r32];
    volatile LAS unsigned* dflag = (volatile LAS unsigned*)(shm + L_FLG);
    if (lane == 0) dflag[wid] = 0u;
    bool wdone = false;
    float qkb2 = 0.f;
    if (KIND == 1) { float g = fabsf(ka->in[8][l * 64 + lane] * ka->in[9][l * 64 + lane]);
#pragma unroll
        for (int o = 1; o < 64; o <<= 1) g = fmaxf(g, __shfl_xor(g, o));
        qkb2 = g * (64.f * QSCALE * 1.02f); }
    for (int i = 0; i < NT; ++i) {
        const int t = NT - 1 - i, slot = (i & 1) * SLOTB;
        if (i + 1 < NT) { DMA_KV(t - 1, SLOTB - slot); asm volatile("s_waitcnt vmcnt(2)" ::: "memory"); } else { asm volatile("s_waitcnt vmcnt(0)" ::: "memory"); }
        __builtin_amdgcn_s_barrier(); asm volatile("" ::: "memory");
        if (t <= tmaxw && !wdone) {
            const bool diag = (t == tmaxw);
            f32x16 p0, p1; u32x4 w0, w1, w2, w3;
            if (KIND == 1) {
                f32x16 cinit;
#pragma unroll
                for (int r = 0; r < 16; ++r) cinit[r] = crow2 - mref;
                qkt(p0, p1, kp0 + slot, qr, cinit);
                LAS const float* csb = cs + 64 * t + 4 * hi;
#pragma unroll
                for (int g = 0; g < 4; ++g) { const f32x4 c0 = *(LAS const f32x4*)(csb + 8 * g), c1 = *(LAS const f32x4*)(csb + 32 + 8 * g);
#pragma unroll
                    for (int e = 0; e < 4; ++e) { p0[4 * g + e] -= c0[e]; p1[4 * g + e] -= c1[e]; } }
                if (diag) {
#pragma unroll
                    for (int r = 0; r < 16; ++r) { const int kr = crow(r, hi); if (kr > rrel) p0[r] = -INFINITY; if (kr + 32 > rrel) p1[r] = -INFINITY; } }
                float rm = fmaxf(p0[0], p1[0]);
#pragma unroll
                for (int r = 1; r < 16; ++r) rm = fmaxf(rm, fmaxf(p0[r], p1[r]));
                rm = half_max(rm);
                if (diag || __any(rm > 8.f)) {
                    const float dl = diag ? rm : fmaxf(rm, 0.f); mref += dl;
#pragma unroll
                    for (int r = 0; r < 16; ++r) { p0[r] -= dl; p1[r] -= dl; }
                    if (!diag) { const float f = __builtin_amdgcn_exp2f(-dl); lsum *= f; if (hi == 0) wsf[r32] = f; LDS_WAIT();
#pragma unroll
                        for (int r = 0; r < 16; ++r) { const float fr_ = wsf[crow(r, hi)]; o[0][r] *= fr_; o[1][r] *= fr_; }
                        LDS_WAIT(); } }
                float sacc = 0.f;
#pragma unroll
                for (int r = 0; r < 16; ++r) { p0[r] = __builtin_amdgcn_exp2f(p0[r]); p1[r] = __builtin_amdgcn_exp2f(p1[r]); sacc += p0[r] + p1[r]; }
                lsum += sacc;
            } else {
                f32x16 z16 = f32x16{};
                qkt(p0, p1, kp0 + slot, qr, z16);
                f32x16 l0, l1;
#pragma unroll
                for (int r = 0; r < 16; ++r) {
                    { const float y = p0[r], sp = fmaxf(y, 0.f) + __builtin_amdgcn_logf(1.f + __builtin_amdgcn_exp2f(-fabsf(y))); l0[r] = -sp; p0[r] = y - sp; }
                    { const float y = p1[r], sp = fmaxf(y, 0.f) + __builtin_amdgcn_logf(1.f + __builtin_amdgcn_exp2f(-fabsf(y))); l1[r] = -sp; p1[r] = y - sp; } }
                if (diag) {
#pragma unroll
                    for (int r = 0; r < 16; ++r) { const int kr = crow(r, hi); if (kr >= rrel) { l0[r] = 0.f; p0[r] = -INFINITY; } if (kr + 32 >= rrel) { l1[r] = 0.f; p1[r] = -INFINITY; } } }
                float run = carry;
#pragma unroll
                for (int blk = 1; blk >= 0; --blk)
#pragma unroll
                    for (int g = 3; g >= 0; --g) {
                        f32x16& L = blk ? l1 : l0; f32x16& P = blk ? p1 : p0;
                        const float a0 = L[4 * g], a1 = L[4 * g + 1], a2 = L[4 * g + 2], a3 = L[4 * g + 3];
                        const float gs = (a0 + a1) + (a2 + a3), T = half_sum(gs);
                        const float base = run + (hi ? 0.f : (T - gs));
                        run += T;
                        const float t3 = base, t2 = t3 + a3, t1 = t2 + a2, t0 = t1 + a1;
                        P[4 * g + 3] = __builtin_amdgcn_exp2f(P[4 * g + 3] + t3); P[4 * g + 2] = __builtin_amdgcn_exp2f(P[4 * g + 2] + t2);
                        P[4 * g + 1] = __builtin_amdgcn_exp2f(P[4 * g + 1] + t1); P[4 * g] = __builtin_amdgcn_exp2f(P[4 * g] + t0);
                    }
                carry = run;
            }
            pack_p(p0, p1, w0, w1, w2, w3);
            pv(o, vp0 + slot, w0, w1, w2, w3);
            if (KIND == 1) { if (t > 0) wdone = __all(qkb2 + crow2 - cs[64 * t - 1] - mref < -152.f); }
            else wdone = __all(carry < -152.f);
            if (wdone && lane == 0) dflag[wid] = 1u;
        }
        LDS_WAIT(); __builtin_amdgcn_s_barrier(); asm volatile("" ::: "memory");
        if (i + 1 < NT) { unsigned nd = 0;
#pragma unroll
            for (int w = 0; w < NWAVES; ++w) nd += dflag[w];
            if (nd == NWAVES) break; }
    }
    asm volatile("s_waitcnt vmcnt(0)" ::: "memory");
#undef DMA_KV
    float rli[16];
    if (KIND == 1) {
        lsum = half_sum(lsum);
        if (hi == 0) wsf[32 + r32] = lsum; LDS_WAIT();
#pragma unroll
        for (int r = 0; r < 16; ++r) rli[r] = __builtin_amdgcn_rcpf(wsf[32 + crow(r, hi)]);
    } else {
#pragma unroll
        for (int r = 0; r < 16; ++r) rli[r] = 1.f;
    }
    bf16_t* Ow = O + (rowbase + q0 + wid * 32) * ldo + h * 64;
    { LAS bf16_t* stg = (LAS bf16_t*)(shm + L_OST) + wid * 2048;
#pragma unroll
      for (int r = 0; r < 16; ++r) { const int orow = crow(r, hi);
#pragma unroll
          for (int d0 = 0; d0 < 2; ++d0) stg[orow * 64 + d0 * 32 + r32] = (bf16_t)(cvt_pk_bf16(o[d0][r] * rli[r], 0.f) & 0xffffu); }
      LDS_WAIT();
#pragma unroll
      for (int i = 0; i < 4; ++i) { const int row = i * 8 + (lane >> 3), ch = lane & 7; const u32x4 v = *(LAS const u32x4*)(stg + row * 64 + ch * 8); if (!dry) *(u32x4*)(Ow + (long)row * ldo + ch * 8) = v; } }
    LDS_WAIT(); __builtin_amdgcn_s_barrier(); asm volatile("" ::: "memory");
}

__device__ __forceinline__ void gmlp_unit(LAS unsigned char* shm, int b, int chunk, int l, bool dry) {
    const int tid = opaque_tid(), lane = tid & 63, r32 = lane & 31, hi = lane >> 5; const int wid = __builtin_amdgcn_readfirstlane(tid >> 6);
    const kargs_t ka = kargs(); bf16_t* mainA = (bf16_t*)ka->out;
    const float* wsp = ka->in[4] + (size_t)l * 4 * 128 * 128; const float* bsp = ka->in[5] + (size_t)l * 4 * 128; const float* lng = ka->in[6] + (size_t)l * 256; const float* lnb = ka->in[7] + (size_t)l * 256;
    const long row0 = (long)b * SEQ + chunk * 128;
    { const int s = 16 * wid + (lane >> 2), g = lane & 3;
      const bf16_t* src = mainA + (row0 + s) * PA + A_V + g * 64;
      u32x4 w[8]; float x[64]; float sum = 0.f;
#pragma unroll
      for (int c = 0; c < 8; ++c) { w[c] = *(const u32x4*)(src + c * 8);
          x[8 * c] = bf_lo(w[c].x); x[8 * c + 1] = bf_hi(w[c].x); x[8 * c + 2] = bf_lo(w[c].y); x[8 * c + 3] = bf_hi(w[c].y);
          x[8 * c + 4] = bf_lo(w[c].z); x[8 * c + 5] = bf_hi(w[c].z); x[8 * c + 6] = bf_lo(w[c].w); x[8 * c + 7] = bf_hi(w[c].w); }
#pragma unroll
      for (int j = 0; j < 64; ++j) sum += x[j];
      sum += __shfl_xor(sum, 1); sum += __shfl_xor(sum, 2);
      const float mu = sum * (1.f / 256.f); float var = 0.f;
#pragma unroll
      for (int j = 0; j < 64; ++j) { x[j] -= mu; var += x[j] * x[j]; }
      var += __shfl_xor(var, 1); var += __shfl_xor(var, 2);
      const float rstd = rsqrtf(var * (1.f / 256.f) + EPS);
      const int st = s >> 6, sr = s & 63;
      LAS unsigned char* dstb = shm + (g * 2 + st) * 8192 + (sr >> 4) * 1024 + (sr & 15) * 64;
#pragma unroll
      for (int c = 0; c < 8; ++c) { f32x4 a, bq;
#pragma unroll
          for (int e = 0; e < 4; ++e) { const int ch = g * 64 + 8 * c + e; a[e] = x[8 * c + e] * rstd * lng[ch] + lnb[ch]; bq[e] = x[8 * c + 4 + e] * rstd * lng[ch + 4] + lnb[ch + 4]; }
          *(LAS u32x4*)(dstb + (c >> 2) * 4096 + (c & 3) * 16) = pg8::pack8(a, bq); }
    }
    LDS_WAIT(); __builtin_amdgcn_s_barrier(); asm volatile("" ::: "memory");
#pragma unroll 1
    for (int jj = 0; jj < 2; ++jj) {
        const int job = wid + 8 * jj, g = job & 3, tb = job >> 2, t = 32 * tb + r32;
        f32x16 o[2]; o[0] = f32x16{}; o[1] = f32x16{};
        const float* wrow = wsp + ((size_t)g * 128 + t) * 128;
        for (int st = 0; st <= (tb >> 1); ++st) {
            u32x4 w4[4];
#pragma unroll
            for (int ks = 0; ks < 4; ++ks) { f32x4 a[2];
#pragma unroll
                for (int j2 = 0; j2 < 2; ++j2) { const int s0 = 64 * st + 16 * ks + 8 * j2 + 4 * hi; a[j2] = *(const f32x4*)(wrow + s0);
#pragma unroll
                    for (int e = 0; e < 4; ++e) if (s0 + e > t) a[j2][e] = 0.f; }
                w4[ks] = pg8::pack8(a[0], a[1]); }
            const lds_cptr vp = (lds_cptr)shm + (g * 2 + st) * 8192 + ((lane >> 4) & 1) * 32 + (lane & 3) * 8 + (4 * hi + ((lane & 15) >> 2)) * 64;
            pv(o, vp, w4[0], w4[1], w4[2], w4[3]);
        }
#pragma unroll
        for (int r = 0; r < 16; ++r) { const int tt = 32 * tb + crow(r, hi); const float bb = bsp[g * 128 + tt];
#pragma unroll
            for (int d0 = 0; d0 < 2; ++d0) { bf16_t* p = mainA + (row0 + tt) * PA + A_YB + g * 64 + d0 * 32 + r32;
                const float uu = __uint_as_float((unsigned)(*p) << 16);
                if (!dry) *p = (bf16_t)(cvt_pk_bf16(uu * (o[d0][r] + bb), 0.f) & 0xffffu); } }
    }
    LDS_WAIT(); __builtin_amdgcn_s_barrier(); asm volatile("" ::: "memory");
}
__device__ __forceinline__ void conv_unit(int unit, int l, bool dry) {
    const int tid = opaque_tid(), cg = tid & 31, rg = tid >> 5;
    const kargs_t ka = kargs(); bf16_t* mainA = (bf16_t*)ka->out; const float* wconv = ka->in[3] + (size_t)l * 3 * 256;
    const int c0 = cg * 8;
    float w[3][8];
#pragma unroll
    for (int k = 0; k < 3; ++k) { const f32x4 a = *(const f32x4*)(wconv + k * 256 + c0), bq = *(const f32x4*)(wconv + k * 256 + c0 + 4);
#pragma unroll
        for (int e = 0; e < 4; ++e) { w[k][e] = a[e]; w[k][4 + e] = bq[e]; } }
    const long rbase = (long)unit * 64 + rg * 4;
    float xc[6][8];
#pragma unroll
    for (int i = 0; i < 6; ++i) { const long row = rbase - 2 + i; const bool ok = (i >= 2) || ((int)(rbase & (SEQ - 1)) + i - 2 >= 0);
        if (ok) { const u32x4 a = *(const u32x4*)(mainA + row * PA + A_CC + c0), bq = *(const u32x4*)(mainA + row * PA + A_CX + c0);
            xc[i][0] = bf_lo(a.x) * bf_lo(bq.x); xc[i][1] = bf_hi(a.x) * bf_hi(bq.x); xc[i][2] = bf_lo(a.y) * bf_lo(bq.y); xc[i][3] = bf_hi(a.y) * bf_hi(bq.y);
            xc[i][4] = bf_lo(a.z) * bf_lo(bq.z); xc[i][5] = bf_hi(a.z) * bf_hi(bq.z); xc[i][6] = bf_lo(a.w) * bf_lo(bq.w); xc[i][7] = bf_hi(a.w) * bf_hi(bq.w); }
        else {
#pragma unroll
            for (int e = 0; e < 8; ++e) xc[i][e] = 0.f; } }
#pragma unroll
    for (int i = 0; i < 4; ++i) { const long row = rbase + i; bf16_t* p = mainA + row * PA + A_YA + c0; const u32x4 cbw = *(const u32x4*)p;
        float cbv[8] = {bf_lo(cbw.x), bf_hi(cbw.x), bf_lo(cbw.y), bf_hi(cbw.y), bf_lo(cbw.z), bf_hi(cbw.z), bf_lo(cbw.w), bf_hi(cbw.w)}; f32x4 o0, o1;
#pragma unroll
        for (int e = 0; e < 4; ++e) { o0[e] = cbv[e] * (w[0][e] * xc[i][e] + w[1][e] * xc[i + 1][e] + w[2][e] * xc[i + 2][e]);
            o1[e] = cbv[4 + e] * (w[0][4 + e] * xc[i][4 + e] + w[1][4 + e] * xc[i + 1][4 + e] + w[2][4 + e] * xc[i + 2][4 + e]); }
        if (!dry) *(u32x4*)p = pg8::pack8(o0, o1); }
}
}

#define XB_TMO      128
#define XB_XCNT(j)  (256  + 64 * (j))
#define XB_XSUB(j)  (1280 + 64 * (j))
#define XB_XGEN(j)  (2304 + 64 * (j))
#define XB_TOP      3328
#define XB_TOPGEN   3392
#define XCD_BAR_WORDS 3456
#define XB_SPIN_CAP (1u << 18)
__device__ __forceinline__ unsigned xb_ld(unsigned* p)              { return __hip_atomic_load(p, __ATOMIC_RELAXED, __HIP_MEMORY_SCOPE_AGENT); }
__device__ __forceinline__ unsigned xb_add(unsigned* p, unsigned v) { return __hip_atomic_fetch_add(p, v, __ATOMIC_RELAXED, __HIP_MEMORY_SCOPE_AGENT); }
__device__ __forceinline__ unsigned xb_xcc_id() { return (unsigned)__builtin_amdgcn_s_getreg((3 << 11) | 20) & 0xFu; }
#define XB_SPIN(cond, bar) do { unsigned _sp = 0; while (cond) { __builtin_amdgcn_s_sleep(1); \
    if ((++_sp & 255u) == 0u) { if (xb_ld(&(bar)[XB_TMO])) break; if (_sp > XB_SPIN_CAP) { atomicAdd(&(bar)[XB_TMO], 1u); break; } } } } while (0)
struct XcdBarrier { unsigned* bar; unsigned x; volatile LAS unsigned* st; };
__device__ __forceinline__ XcdBarrier xcd_barrier_post(unsigned* bar, volatile LAS unsigned* st) {
    XcdBarrier b; b.bar = bar; b.x = xb_xcc_id(); b.st = st;
    if (threadIdx.x == 0) (void)xb_add(&bar[XB_XCNT(b.x)], 1u);
    return b;
}
__device__ __forceinline__ void xcd_barrier_complete(unsigned* bar, unsigned x, unsigned& nloc, unsigned& nx) {
    const unsigned G = gridDim.x * gridDim.y * gridDim.z;
    unsigned sum, cnt, mine, sp = 0u;
    for (;;) {
        sum = 0u; cnt = 0u; mine = 0u;
#pragma unroll
        for (unsigned j = 0; j < 16; ++j) { const unsigned c = xb_ld(&bar[XB_XCNT(j)]); sum += c; cnt += (c > 0u) ? 1u : 0u; mine = (j == x) ? c : mine; }
        if (sum == G) break;
        __builtin_amdgcn_s_sleep(1);
        if ((++sp & 255u) == 0u) { if (xb_ld(&bar[XB_TMO])) break; if (sp > XB_SPIN_CAP) { atomicAdd(&bar[XB_TMO], 1u); break; } }
    }
    nloc = mine > 0u ? mine : 1u; nx = cnt > 0u ? cnt : 1u;
}
__device__ __forceinline__ void xcd_barrier(const XcdBarrier& b) {
    asm volatile("s_waitcnt vmcnt(0)" ::: "memory");
    __syncthreads();
    if (threadIdx.x == 0) {
        unsigned* bar = b.bar;
        __builtin_amdgcn_s_waitcnt(0);
        unsigned nloc = b.st[0], nx = b.st[1];
        if (nloc == 0u) { xcd_barrier_complete(bar, b.x, nloc, nx); b.st[0] = nloc; b.st[1] = nx; }
        const unsigned old = xb_add(&bar[XB_XSUB(b.x)], 1u);
        const unsigned gen = old / nloc;
        if (old + 1u == (gen + 1u) * nloc) {
            __builtin_amdgcn_fence(__ATOMIC_RELEASE, "agent");
            asm volatile("s_waitcnt vmcnt(0)" ::: "memory");
            const unsigned og = xb_add(&bar[XB_TOP], 1u);
            const unsigned tg = og / nx;
            if (og + 1u == (tg + 1u) * nx) xb_add(&bar[XB_TOPGEN], 1u);
            else XB_SPIN(xb_ld(&bar[XB_TOPGEN]) == tg, bar);
            __builtin_amdgcn_fence(__ATOMIC_ACQUIRE, "agent");
            xb_add(&bar[XB_XGEN(b.x)], 1u);
            asm volatile("s_waitcnt vmcnt(0)" ::: "memory");
        } else {
            XB_SPIN(xb_ld(&bar[XB_XGEN(b.x)]) == gen, bar);
            __builtin_amdgcn_fence(__ATOMIC_ACQUIRE, "agent");
            asm volatile("s_waitcnt vmcnt(0)" ::: "memory");
        }
    }
    __syncthreads();
}

__device__ __forceinline__ float wave_sum(float v) {
#pragma unroll
    for (int o = 1; o < 64; o <<= 1) v += __shfl_xor(v, o);
    return v;
}
__device__ __forceinline__ void tr_item(const float* W, int ldw, const float* ks, bf16_t* WT, int K, int k0, int p0, int src0, int nvalid, LAS float* scr, int lane) {
    const int n = lane & 31, kh = lane >> 5;
    float v[32];
    if (n < nvalid) {
        const float* wp = W + (size_t)(k0 + kh) * ldw + src0 + n;
#pragma unroll
        for (int i = 0; i < 32; ++i) v[i] = wp[(size_t)(2 * i) * ldw];
        if (ks) {
            float g[32];
#pragma unroll
            for (int i = 0; i < 32; ++i) g[i] = ks[k0 + 2 * i + kh];
#pragma unroll
            for (int i = 0; i < 32; ++i) v[i] *= g[i];
        }
    } else {
#pragma unroll
        for (int i = 0; i < 32; ++i) v[i] = 0.f;
    }
#pragma unroll
    for (int i = 0; i < 32; ++i) scr[(2 * i + kh) * 33 + n] = v[i];
    LDS_WAIT(); asm volatile("" ::: "memory");
    const int c = lane & 7;
#pragma unroll
    for (int j = 0; j < 4; ++j) { const int nn = (lane >> 3) + 8 * j; const LAS float* s = scr + (8 * c) * 33 + nn;
        u32x4 o; o.x = cvt_pk_bf16(s[0 * 33], s[1 * 33]); o.y = cvt_pk_bf16(s[2 * 33], s[3 * 33]); o.z = cvt_pk_bf16(s[4 * 33], s[5 * 33]); o.w = cvt_pk_bf16(s[6 * 33], s[7 * 33]);
        *(u32x4*)(WT + (size_t)(p0 + nn) * K + k0 + 8 * c) = o; }
    LDS_WAIT(); asm volatile("" ::: "memory");
}

constexpr int I_IN = 16 * (NP1 / 32), I_BR = 4 * 4 * 32, I_OUT = 16 * 32, I_F1 = 16 * (NF1 / 32), I_F2 = (FF / 64) * 32, I_REST = I_BR + I_OUT + I_F1 + I_F2;
__device__ __forceinline__ void convert_item(int l, int idx, LAS float* scr, int lane) {
    const kargs_t ka = kargs(); unsigned char* ws = ka->ws;
    int r = idx;
    if (r < I_IN) { const int kb = r / (NP1 / 32), nb = r % (NP1 / 32), pn = nb >> 3, q = nb & 7, chb = 64 * (q & 3) + 32 * (q >> 2);
        int src0, nvalid = 32;
        if (pn <= 10) src0 = 256 * pn + chb; else if (pn <= 26) src0 = 2820 + 256 * (pn - 11) + chb; else { src0 = 2816; nvalid = (q == 0) ? 4 : 0; }
        tr_item(ka->in[2] + (size_t)l * DM * NIN, NIN, ka->in[1] + (size_t)l * DM, (bf16_t*)(ws + WS_WIN), DM, 64 * kb, 32 * nb, src0, nvalid, scr, lane); return; }
    r -= I_IN;
    if (r < I_BR) { const int z = r / 128, rr = r % 128, kb = rr / 32, nb = rr % 32;
        tr_item(ka->in[11] + ((size_t)l * 4 + z) * 256 * DM, DM, nullptr, (bf16_t*)(ws + WS_WBR) + (size_t)z * DM * 256, 256, 64 * kb, 32 * nb, 32 * nb, 32, scr, lane); return; }
    r -= I_BR;
    if (r < I_OUT) { const int kb = r / 32, nb = r % 32; tr_item(ka->in[12] + (size_t)l * DM * DM, DM, nullptr, (bf16_t*)(ws + WS_WOUT), DM, 64 * kb, 32 * nb, 32 * nb, 32, scr, lane); return; }
    r -= I_OUT;
    if (r < I_F1) { const int kb = r / (NF1 / 32), nb = r % (NF1 / 32), pn = nb >> 3, q = nb & 7;
        tr_item(ka->in[14] + (size_t)l * DM * NF1, NF1, ka->in[13] + (size_t)l * DM, (bf16_t*)(ws + WS_WF1), DM, 64 * kb, 32 * nb, ((q >> 2) ? FF : 0) + 128 * pn + 32 * (q & 3), 32, scr, lane); return; }
    r -= I_F1;
    { const int kb = r / 32, nb = r % 32; tr_item(ka->in[15] + (size_t)l * FF * DM, DM, nullptr, (bf16_t*)(ws + WS_WF2), FF, 64 * kb, 32 * nb, 32 * nb, 32, scr, lane); }
}

constexpr int PH_PER_LAYER = 7, N_PHASES = DEPTH * PH_PER_LAYER;

__global__ void __launch_bounds__(NWAVES * 64, 2) mk_fwd(Args args) {
    extern __shared__ __attribute__((aligned(16))) unsigned char lds_raw[];
    LAS unsigned char* lds = (LAS unsigned char*)lds_raw;
    volatile LAS unsigned* MISC = (volatile LAS unsigned*)(lds + MISC_OFF);
    const int G = gridDim.x, bx = blockIdx.x;
    { const int tid = threadIdx.x; for (int u = tid; u < (LDS_BYTES - LDSCTL_OFF) / 4; u += NWAVES * 64) ((LAS unsigned*)(lds + LDSCTL_OFF))[u] = 0u; }
    __syncthreads();
    XcdBarrier bar = xcd_barrier_post((unsigned*)(args.ws + WS_CTL) + CW_BAR, MISC + 8);
    const int lo_ph = args.ph_lo, hi_ph = args.ph_hi;
#ifndef PHMASK
#define PHMASK 0x7f
#endif
#define IN(k) (((PHMASK >> ((k) % PH_PER_LAYER)) & 1) && lo_ph <= (k) && (k) < hi_ph)
#define SEAM(k) do { if (lo_ph <= (k) && (k) + 1 < hi_ph) xcd_barrier(bar); } while (0)
#ifndef PROBE_DUP
#define PROBE_DUP 0
#endif
#define REPS(k) (((PROBE_DUP >> (k)) & 1) ? 2 : 1)

#pragma unroll 1
    for (int l = 0; l < DEPTH; ++l) {
        const int pb = l * PH_PER_LAYER;
        for (int rep = 0; rep < REPS(0); ++rep) if (l == 0 && IN(pb + 0)) {
            const int tid = opaque_tid(), lane = tid & 63, wave = __builtin_amdgcn_readfirstlane(tid >> 6);
            const int vcu = (G % 8 == 0) ? (bx % 8) * (G / 8) + bx / 8 : bx;
            const kargs_t ka = kargs(); unsigned char* ws = ka->ws;
            LAS float* scr = (LAS float*)(lds + wave * 16384);
            const int gw = vcu * NWAVES + wave, NGW = G * NWAVES;
#pragma unroll 1
            for (int it = gw; it < I_IN; it += NGW) convert_item(0, it, scr, lane);
            if (l == 0) {
                const float* x = ka->in[0]; bf16_t* HB = (bf16_t*)(ws + WS_HB); bf16_t* LO = (bf16_t*)(ws + WS_LO); float* part = (float*)(ws + WS_PART);
#pragma unroll 1
                for (int m = gw; m < M; m += NGW) {
                    const f32x4* xr = (const f32x4*)(x + (size_t)m * DM) + lane; f32x4 v[4]; float s = 0.f;
#pragma unroll
                    for (int j = 0; j < 4; ++j) { v[j] = xr[64 * j]; s += (v[j][0] * v[j][0] + v[j][1] * v[j][1]) + (v[j][2] * v[j][2] + v[j][3] * v[j][3]); }
                    s = wave_sum(s);
                    u32x2* hb8 = (u32x2*)(HB + (size_t)m * DM) + lane; u32x2* lo8 = (u32x2*)(LO + (size_t)m * DM) + lane;
#pragma unroll
                    for (int j = 0; j < 4; ++j) { u32x2 hw; hw.x = cvt_pk_bf16(v[j][0], v[j][1]); hw.y = cvt_pk_bf16(v[j][2], v[j][3]);
                        u32x2 lw; lw.x = cvt_pk_bf16(v[j][0] - bf_lo(hw.x), v[j][1] - bf_hi(hw.x)); lw.y = cvt_pk_bf16(v[j][2] - bf_lo(hw.y), v[j][3] - bf_hi(hw.y));
                        hb8[64 * j] = hw; lo8[64 * j] = lw; }
                    if (lane < 16) part[(size_t)m * 16 + lane] = (lane == 0) ? s : 0.f;
                }
            }
        }
        if (l == 0) SEAM(pb + 0);
        for (int rep = 0; rep < REPS(1); ++rep) if (IN(pb + 1)) {
            const kargs_t ka = kargs();
            pg8::Gemm g{(const bf16_t*)(ka->ws + WS_HB), (const bf16_t*)(ka->ws + WS_WIN), DM, DM, 0, 0}; pg8::StaticOrder S; S.init(M, NP1, G, bx);
            pg8::EpiP1 E{l};
            pg8::gemm_phase(lds, g, S, E);
        }
        SEAM(pb + 1);
        for (int rep = 0; rep < REPS(2); ++rep) if (IN(pb + 2)) {
            const bool dry = (REPS(2) == 2) && (rep + lo_ph == 0);
            constexpr int N_ATT = 512, N_GM = 128, N_CV = M / 64, N_WB = I_REST / 32, N_WA = I_IN / 32;
            const int n_w = N_WB + ((l + 1 < DEPTH) ? N_WA : 0), N_ITEMS = N_ATT + n_w + N_GM + N_CV;
#pragma unroll 1
            for (;;) {
                if (threadIdx.x == 0) { const kargs_t ka = kargs(); MISC[16] = xb_add((unsigned*)(ka->ws + WS_CTL) + CW_QUEUE + 64 * (l + 2 * rep), 1u); }
                __syncthreads();
                int it = (int)MISC[16];
                __syncthreads();
                it = __builtin_amdgcn_readfirstlane(it);
                if (it >= N_ITEMS) break;
                if (it < N_ATT) { const int qb = 7 - (it >> 6), kind = (it >> 5) & 1, bh = it & 31, b = bh >> 2, h = bh & 3;
                    if (kind) mix::attn_unit<1>(lds, b, h, qb, l, dry); else mix::attn_unit<0>(lds, b, h, qb, l, dry);
                } else if (it < N_ATT + n_w) {
                    const int j = it - N_ATT; const int tid = opaque_tid(), lane = tid & 63, wave = __builtin_amdgcn_readfirstlane(tid >> 6);
                    LAS float* scr = (LAS float*)(lds + wave * 16384);
#pragma unroll 1
                    for (int k = 0; k < 4; ++k) { if (j < N_WB) convert_item(l, I_IN + 32 * j + wave + 8 * k, scr, lane); else convert_item(l + 1, 32 * (j - N_WB) + wave + 8 * k, scr, lane); }
                    __syncthreads();
                } else if (it < N_ATT + n_w + N_GM) { const int j = it - N_ATT - n_w; mix::gmlp_unit(lds, j >> 4, j & 15, l, dry); }
                else mix::conv_unit(it - N_ATT - n_w - N_GM, l, dry);
            }
        }
        SEAM(pb + 2);
        for (int rep = 0; rep < REPS(3); ++rep) if (IN(pb + 3)) {
            const kargs_t ka = kargs();
            pg8::Gemm g{(const bf16_t*)ka->out, (const bf16_t*)(ka->ws + WS_WBR), PA, 256, 256, (size_t)DM * 256}; pg8::BranchOrder S; S.s.init(M, DM, G, bx);
            pg8::EpiBranch E{0};
            pg8::gemm_phase(lds, g, S, E);
        }
        SEAM(pb + 3);
        for (int rep = 0; rep < REPS(4); ++rep) if (IN(pb + 4)) {
            const bool dry = (REPS(4) == 2) && (rep + lo_ph == 0);
            const kargs_t ka = kargs();
            pg8::Gemm g{(const bf16_t*)ka->out + A_MRG, (const bf16_t*)(ka->ws + WS_WOUT), PA, DM, 0, 0}; pg8::StaticOrder S; S.init(M, DM, G, bx);
            pg8::EpiRes E{0, dry};
            pg8::gemm_phase(lds, g, S, E);
        }
        SEAM(pb + 4);
        for (int rep = 0; rep < REPS(5); ++rep) if (IN(pb + 5)) {
            const kargs_t ka = kargs();
            pg8::Gemm g{(const bf16_t*)(ka->ws + WS_HB), (const bf16_t*)(ka->ws + WS_WF1), DM, DM, 0, 0}; pg8::StaticOrder S; S.init(M, NF1, G, bx);
            pg8::EpiSwiglu E{0};
            pg8::gemm_phase(lds, g, S, E);
        }
        SEAM(pb + 5);
        for (int rep = 0; rep < REPS(6); ++rep) if (IN(pb + 6)) {
            const bool dry = (REPS(6) == 2) && (rep + lo_ph == 0);
            const kargs_t ka = kargs();
            pg8::Gemm g{(const bf16_t*)(ka->ws + WS_GATES), (const bf16_t*)(ka->ws + WS_WF2), FF, FF, 0, 0}; pg8::StaticOrder S; S.init(M, DM, G, bx);
            pg8::EpiRes E{(l == DEPTH - 1) ? 1 : 0, dry};
            pg8::gemm_phase(lds, g, S, E);
        }
        if (l + 1 < DEPTH) SEAM(pb + 6);
    }
#undef IN
#undef SEAM
}

#ifndef MK_PER_PHASE
#define MK_PER_PHASE 0
#endif
extern "C" void kernel_launch(void* const* d_in, const int* in_sizes, int n_in, void* d_out, int out_size, void* d_ws, size_t ws_size, hipStream_t stream) {
    static int grid = 0;
    if (grid == 0) {
        if (n_in != 16 || out_size != M * DM || ws_size < WS_END) { fprintf(stderr, "kernel_launch: unexpected shapes (n_in %d out %d ws %zu)\n", n_in, out_size, ws_size); grid = -1; return; }
        int dev = 0, cus = 0, per_cu = 0;
        if (hipGetDevice(&dev) != hipSuccess || hipDeviceGetAttribute(&cus, hipDeviceAttributeMultiprocessorCount, dev) != hipSuccess) { grid = -1; return; }
        if (hipFuncSetAttribute((const void*)mk_fwd, hipFuncAttributeMaxDynamicSharedMemorySize, LDS_BYTES) != hipSuccess) { fprintf(stderr, "kernel_launch: hipFuncSetAttribute failed\n"); grid = -1; return; }
        if (hipOccupancyMaxActiveBlocksPerMultiprocessor(&per_cu, (const void*)mk_fwd, NWAVES * 64, LDS_BYTES) != hipSuccess || per_cu < 1) { fprintf(stderr, "kernel_launch: occupancy query says %d blocks per CU\n", per_cu); }
        (void)hipGetLastError();
        grid = cus;
        if (grid != 256) fprintf(stderr, "kernel_launch: %d CUs (built for 256)\n", grid);
    }
    if (grid < 0) return;
    (void)hipMemsetAsync((char*)d_ws + WS_CTL, 0, CTL_ZERO_BYTES, stream);
    Args a{};
    for (int i = 0; i < 16; ++i) a.in[i] = (const float*)d_in[i];
    a.out = (float*)d_out; a.ws = (unsigned char*)d_ws;
#if MK_PER_PHASE
    for (int p = 0; p < N_PHASES; ++p) { a.ph_lo = p; a.ph_hi = p + 1; hipLaunchKernelGGL(mk_fwd, dim3(grid), dim3(NWAVES * 64), LDS_BYTES, stream, a); }
#else
    a.ph_lo = 0; a.ph_hi = N_PHASES;
    void* kargs[] = {&a};
    hipError_t e = hipLaunchCooperativeKernel((const void*)mk_fwd, dim3(grid), dim3(NWAVES * 64), kargs, LDS_BYTES, stream);
    if (e != hipSuccess) fprintf(stderr, "kernel_launch: cooperative launch failed: %s\n", hipGetErrorString(e));
#endif
}
```
